# Optimizing an MI355X kernel written in HIP

```python
import math
import jax, jax.numpy as jnp
from jax import lax
import numpy as np


D_MODEL = 1024
BATCH = 2
SEQ = 16384
DEPTH = 1
DEC_BATCH = 4
DEC_SEQ = 8192
PAST_LEN = 128

QK_DIM = 64
V_DIM = 2 * QK_DIM
N_HEADS = D_MODEL // V_DIM
ATTN_WIDTH = N_HEADS * V_DIM
Q_WIDTH = N_HEADS * 2 * QK_DIM
ROT_DIM = QK_DIM // 4
ROPE_THETA = 500000.0
Q_BLOCK = 128
SSM_GROUP_SIZE = 16
SSM_WIDTH = D_MODEL // 2
SSM_GROUPS = SSM_WIDTH // SSM_GROUP_SIZE
SSM_STATE = 64
LOG_STEP_MIN = math.log(1e-3)
LOG_STEP_MAX = math.log(1e-1)
N_BRANCH = 2
IN_WIDTH = 2 * Q_WIDTH + ATTN_WIDTH + SSM_WIDTH + N_BRANCH * D_MODEL
SPLITS = (Q_WIDTH, 2 * Q_WIDTH, 2 * Q_WIDTH + ATTN_WIDTH, 2 * Q_WIDTH + ATTN_WIDTH + SSM_WIDTH)
D_FF = 4 * D_MODEL
N_MOD = 6
EPS = 1e-6

kernel_name = 'hybrid_diffattn_s5_encoder'


def rmsnorm(x, g):
    xf = x.astype(jnp.float32)
    y = xf * lax.rsqrt(jnp.mean(xf * xf, axis=-1, keepdims=True) + EPS) * g.astype(jnp.float32)
    return y.astype(x.dtype)


def rope_tables(L):
    pos = jnp.arange(L, dtype=jnp.float32)
    inv_freq = ROPE_THETA ** (-jnp.arange(0, ROT_DIM, 2, dtype=jnp.float32) / ROT_DIM)
    ang = pos[:, None] * inv_freq[None, :]
    return jnp.cos(ang)[None, :, None, None, :], jnp.sin(ang)[None, :, None, None, :]


def partial_rope(t, cos, sin):
    half = ROT_DIM // 2
    x1 = t[..., :half].astype(jnp.float32)
    x2 = t[..., half:ROT_DIM].astype(jnp.float32)
    rot = jnp.concatenate([x1 * cos - x2 * sin, x2 * cos + x1 * sin], axis=-1).astype(t.dtype)
    return jnp.concatenate([rot, t[..., ROT_DIM:]], axis=-1)


def diff_attention(q, k, v, lam, g_head, lam_init):
    Bn, L = q.shape[0], q.shape[1]
    nb = L // Q_BLOCK
    qb = (q * (QK_DIM ** -0.5)).reshape(Bn, nb, Q_BLOCK, N_HEADS, 2, QK_DIM).transpose(1, 0, 2, 3, 4, 5)

    def block(qblk):
        s = jnp.einsum('bqhmd,bkhmd->bhmqk', qblk, k, preferred_element_type=jnp.float32)
        p = jax.nn.softmax(s, axis=-1)
        a = p[:, :, 0] - lam * p[:, :, 1]
        return jnp.einsum('bhqk,bkhe->bqhe', a.astype(v.dtype), v)

    o = lax.map(block, qb)
    o = o.transpose(1, 0, 2, 3, 4).reshape(Bn, L, N_HEADS, V_DIM)
    o = rmsnorm(o, g_head) * (1.0 - lam_init)
    return o.reshape(Bn, L, ATTN_WIDTH)


def zoh(lam_re, lam_im, log_step, b_re, b_im):
    lam_re = lam_re.astype(jnp.float32)
    lam_im = lam_im.astype(jnp.float32)
    step = jnp.exp(log_step.astype(jnp.float32))[:, None]
    er = jnp.exp(lam_re * step)
    ar = er * jnp.cos(lam_im * step)
    ai = er * jnp.sin(lam_im * step)
    den = lam_re * lam_re + lam_im * lam_im
    nr = ar - 1.0
    cr = ((nr * lam_re + ai * lam_im) / den)[..., None]
    ci = ((ai * lam_re - nr * lam_im) / den)[..., None]
    b_re = b_re.astype(jnp.float32)
    b_im = b_im.astype(jnp.float32)
    return ar, ai, cr * b_re - ci * b_im, cr * b_im + ci * b_re


def complex_scan_op(e1, e2):
    a1r, a1i, b1r, b1i = e1
    a2r, a2i, b2r, b2i = e2
    return (a2r * a1r - a2i * a1i,
            a2r * a1i + a2i * a1r,
            a2r * b1r - a2i * b1i + b2r,
            a2r * b1i + a2i * b1r + b2i)


def s5_scan(u, lam_re, lam_im, log_step, b_re, b_im, c_re, c_im, reverse):
    ar, ai, bbr, bbi = zoh(lam_re, lam_im, log_step, b_re, b_im)
    bu_r = jnp.einsum('blgp,gnp->blgn', u, bbr)
    bu_i = jnp.einsum('blgp,gnp->blgn', u, bbi)
    a_r = jnp.broadcast_to(ar, bu_r.shape)
    a_i = jnp.broadcast_to(ai, bu_i.shape)
    _, _, sr, si = lax.associative_scan(complex_scan_op, (a_r, a_i, bu_r, bu_i), reverse=reverse, axis=1)
    return (jnp.einsum('blgn,gpn->blgp', sr, c_re.astype(jnp.float32))
            - jnp.einsum('blgn,gpn->blgp', si, c_im.astype(jnp.float32)))


def s5_branch(u, p):
    Bn, L, _ = u.shape
    uf = u.astype(jnp.float32).reshape(Bn, L, SSM_GROUPS, SSM_GROUP_SIZE)
    y_f = s5_scan(uf, p['ssm_lam_re_f'], p['ssm_lam_im_f'], p['ssm_log_step_f'], p['ssm_b_re'], p['ssm_b_im'],
                  p['ssm_c_re_f'], p['ssm_c_im_f'], False)
    y_b = s5_scan(uf, p['ssm_lam_re_b'], p['ssm_lam_im_b'], p['ssm_log_step_b'], p['ssm_b_re'], p['ssm_b_im'],
                  p['ssm_c_re_b'], p['ssm_c_im_b'], True)
    y = (y_f + y_b + uf * p['ssm_d'].astype(jnp.float32)).reshape(Bn, L, SSM_WIDTH)
    yg = jax.nn.gelu(y)
    out = yg * jax.nn.sigmoid(yg @ p['w_glu'].astype(jnp.float32) + p['b_glu'].astype(jnp.float32))
    return out.astype(u.dtype)


def mixer(h, p, lam_init):
    Bn, L, _ = h.shape
    z = h @ p['w_in']
    q, k, v, u, gates = jnp.split(z, SPLITS, axis=-1)
    cos, sin = rope_tables(L)
    q = partial_rope(q.reshape(Bn, L, N_HEADS, 2, QK_DIM), cos, sin)
    k = partial_rope(k.reshape(Bn, L, N_HEADS, 2, QK_DIM), cos, sin)
    v = v.reshape(Bn, L, N_HEADS, V_DIM)
    f32 = jnp.float32
    lam = (jnp.exp(jnp.sum(p['lam_q1'].astype(f32) * p['lam_k1'].astype(f32)))
           - jnp.exp(jnp.sum(p['lam_q2'].astype(f32) * p['lam_k2'].astype(f32))) + lam_init)
    attn = diff_attention(q, k, v, lam, p['g_head'], lam_init)
    ssm = s5_branch(u, p)
    g_a, g_s = jnp.split(jax.nn.sigmoid(gates.astype(f32)).astype(h.dtype), N_BRANCH, axis=-1)
    merged = g_a * (attn @ p['w_proj_attn']) + g_s * (ssm @ p['w_proj_ssm'])
    return merged @ p['w_out']


def encoder_layer(x, c, p, lam_init):
    mod = jax.nn.silu(c) @ p['w_ada'] + p['b_ada']
    sh1, sc1, gt1, sh2, sc2, gt2 = [m[:, None, :] for m in jnp.split(mod, N_MOD, axis=-1)]
    h = rmsnorm(x, p['g_pre_mix']) * (1 + sc1) + sh1
    x = x + gt1 * rmsnorm(mixer(h, p, lam_init), p['g_post_mix'])
    h = rmsnorm(x, p['g_pre_ffn']) * (1 + sc2) + sh2
    f = jnp.square(jax.nn.relu(h @ p['w_ff1'])) @ p['w_ff2']
    return x + gt2 * rmsnorm(f, p['g_post_ffn'])


def setup_inputs(seed: int = 0) -> dict:
    key = jax.random.key(seed)
    ks = iter(jax.random.split(key, 48))
    f32 = jnp.float32

    def nrm(shape, scale):
        return jax.random.normal(next(ks), shape, f32) * scale

    Ld, G, N, P = DEPTH, SSM_GROUPS, SSM_STATE, SSM_GROUP_SIZE
    n_idx = jnp.arange(N, dtype=f32)

    def lam_re():
        return -0.5 + nrm((Ld, G, N), 0.01)

    def lam_im():
        return math.pi * n_idx + nrm((Ld, G, N), 0.01)

    def log_step():
        return jax.random.uniform(next(ks), (Ld, G), f32, LOG_STEP_MIN, LOG_STEP_MAX)

    return {
        'x_prompt': nrm((BATCH, SEQ, D_MODEL), 1.0),
        'x_sample': nrm((DEC_BATCH, DEC_SEQ, D_MODEL), 1.0),
        'c_prompt': nrm((BATCH, D_MODEL), 1.0),
        'c_sample': nrm((DEC_BATCH, D_MODEL), 1.0),
        'w_ada': nrm((Ld, D_MODEL, N_MOD * D_MODEL), D_MODEL ** -0.5),
        'b_ada': nrm((Ld, N_MOD * D_MODEL), 0.02),
        'g_pre_mix': 1.0 + nrm((Ld, D_MODEL), 0.02),
        'g_post_mix': 1.0 + nrm((Ld, D_MODEL), 0.02),
        'g_pre_ffn': 1.0 + nrm((Ld, D_MODEL), 0.02),
        'g_post_ffn': 1.0 + nrm((Ld, D_MODEL), 0.02),
        'w_in': nrm((Ld, D_MODEL, IN_WIDTH), D_MODEL ** -0.5),
        'lam_q1': nrm((Ld, QK_DIM), 0.1),
        'lam_k1': nrm((Ld, QK_DIM), 0.1),
        'lam_q2': nrm((Ld, QK_DIM), 0.1),
        'lam_k2': nrm((Ld, QK_DIM), 0.1),
        'g_head': 1.0 + nrm((Ld, V_DIM), 0.02),
        'ssm_lam_re_f': lam_re(),
        'ssm_lam_im_f': lam_im(),
        'ssm_log_step_f': log_step(),
        'ssm_c_re_f': nrm((Ld, G, P, N), (2 * N) ** -0.5),
        'ssm_c_im_f': nrm((Ld, G, P, N), (2 * N) ** -0.5),
        'ssm_lam_re_b': lam_re(),
        'ssm_lam_im_b': lam_im(),
        'ssm_log_step_b': log_step(),
        'ssm_c_re_b': nrm((Ld, G, P, N), (2 * N) ** -0.5),
        'ssm_c_im_b': nrm((Ld, G, P, N), (2 * N) ** -0.5),
        'ssm_b_re': nrm((Ld, G, N, P), (2 * P) ** -0.5),
        'ssm_b_im': nrm((Ld, G, N, P), (2 * P) ** -0.5),
        'ssm_d': nrm((Ld, G, P), 1.0),
        'w_glu': nrm((Ld, SSM_WIDTH, SSM_WIDTH), SSM_WIDTH ** -0.5),
        'b_glu': nrm((Ld, SSM_WIDTH), 0.02),
        'w_proj_attn': nrm((Ld, ATTN_WIDTH, D_MODEL), ATTN_WIDTH ** -0.5),
        'w_proj_ssm': nrm((Ld, SSM_WIDTH, D_MODEL), SSM_WIDTH ** -0.5),
        'w_out': nrm((Ld, D_MODEL, D_MODEL), D_MODEL ** -0.5),
        'w_ff1': nrm((Ld, D_MODEL, D_FF), D_MODEL ** -0.5),
        'w_ff2': nrm((Ld, D_FF, D_MODEL), D_FF ** -0.5),
    }


def reference(x_prompt, x_sample, c_prompt, c_sample, w_ada, b_ada, g_pre_mix, g_post_mix, g_pre_ffn, g_post_ffn,
              w_in, lam_q1, lam_k1, lam_q2, lam_k2, g_head,
              ssm_lam_re_f, ssm_lam_im_f, ssm_log_step_f, ssm_c_re_f, ssm_c_im_f,
              ssm_lam_re_b, ssm_lam_im_b, ssm_log_step_b, ssm_c_re_b, ssm_c_im_b,
              ssm_b_re, ssm_b_im, ssm_d, w_glu, b_glu, w_proj_attn, w_proj_ssm, w_out, w_ff1, w_ff2):
    y_prompt = x_prompt
    y_sample = x_sample
    for l in range(DEPTH):
        p = dict(w_ada=w_ada[l], b_ada=b_ada[l], g_pre_mix=g_pre_mix[l], g_post_mix=g_post_mix[l],
                 g_pre_ffn=g_pre_ffn[l], g_post_ffn=g_post_ffn[l], w_in=w_in[l],
                 lam_q1=lam_q1[l], lam_k1=lam_k1[l], lam_q2=lam_q2[l], lam_k2=lam_k2[l], g_head=g_head[l],
                 ssm_lam_re_f=ssm_lam_re_f[l], ssm_lam_im_f=ssm_lam_im_f[l], ssm_log_step_f=ssm_log_step_f[l],
                 ssm_c_re_f=ssm_c_re_f[l], ssm_c_im_f=ssm_c_im_f[l],
                 ssm_lam_re_b=ssm_lam_re_b[l], ssm_lam_im_b=ssm_lam_im_b[l], ssm_log_step_b=ssm_log_step_b[l],
                 ssm_c_re_b=ssm_c_re_b[l], ssm_c_im_b=ssm_c_im_b[l],
                 ssm_b_re=ssm_b_re[l], ssm_b_im=ssm_b_im[l], ssm_d=ssm_d[l], w_glu=w_glu[l], b_glu=b_glu[l],
                 w_proj_attn=w_proj_attn[l], w_proj_ssm=w_proj_ssm[l], w_out=w_out[l],
                 w_ff1=w_ff1[l], w_ff2=w_ff2[l])
        lam_init = 0.8 - 0.6 * math.exp(-0.3 * l)
        y_prompt = encoder_layer(y_prompt, c_prompt, p, lam_init)
        y_sample = encoder_layer(y_sample, c_sample, p, lam_init)
    return (y_prompt, y_sample)
```

```cpp
#include <hip/hip_runtime.h>
#include <hip/hip_cooperative_groups.h>
#include <cstdint>
#include <cstdio>
namespace cg = cooperative_groups;

#define DI __device__ __forceinline__
typedef unsigned short bf16_t;
typedef short bf16x8 __attribute__((ext_vector_type(8)));
typedef short s16x4 __attribute__((ext_vector_type(4)));
typedef float f32x16 __attribute__((ext_vector_type(16)));
typedef __bf16 bf2_t __attribute__((ext_vector_type(2)));
typedef float f2_t __attribute__((ext_vector_type(2)));
#define MFMA32(a, b, c) __builtin_amdgcn_mfma_f32_32x32x16_bf16((a), (b), (c), 0, 0, 0)
#define LDS3 __attribute__((address_space(3)))

constexpr int NT = 512;
constexpr int D = 1024, DFF = 4096, INW = 5632;
constexpr int HALF_TOK = 32768;
constexpr int TCH = 32;
constexpr int NCH = HALF_TOK / TCH;

constexpr size_t SZ_WIN = (size_t)INW * D * 2, SZ_WPA = (size_t)D * D * 2, SZ_WPS = (size_t)D * 512 * 2, SZ_WGLU = 512 * 512 * 2,
                 SZ_WOUT = (size_t)D * D * 2, SZ_WFF = (size_t)D * DFF * 2, SZ_WEND = (size_t)32 * 256 * 512 * 2,
                 SZ_WTOEP = (size_t)32 * 512 * 768 * 2, SZ_KTAB = (size_t)32 * 2 * 32 * 256 * 4, SZ_MOD = 6 * 6144 * 4,
                 SZ_ROPE = (size_t)16384 * 8 * 2 * 4;
constexpr size_t OFF_WIN = 0, OFF_WPA = OFF_WIN + SZ_WIN, OFF_WPS = OFF_WPA + SZ_WPA, OFF_WGLU = OFF_WPS + SZ_WPS,
                 OFF_WOUT = OFF_WGLU + SZ_WGLU, OFF_WFF1 = OFF_WOUT + SZ_WOUT, OFF_WFF2 = OFF_WFF1 + SZ_WFF,
                 OFF_WEND = OFF_WFF2 + SZ_WFF, OFF_WTOEP = OFF_WEND + SZ_WEND, OFF_KTAB = OFF_WTOEP + SZ_WTOEP,
                 OFF_MOD = OFF_KTAB + SZ_KTAB, OFF_ROPE = OFF_MOD + SZ_MOD, OFF_SCAL = OFF_ROPE + SZ_ROPE,
                 OFF_KMAX = OFF_SCAL + 256, OFF_H1 = OFF_SCAL + 1024;
constexpr size_t SZ_TOK1K = (size_t)HALF_TOK * 1024 * 2;
constexpr size_t OFF_Q = OFF_H1 + SZ_TOK1K, OFF_K = OFF_Q + SZ_TOK1K, OFF_V = OFF_K + SZ_TOK1K, OFF_U = OFF_V + SZ_TOK1K,
                 OFF_GATES = OFF_U + SZ_TOK1K / 2, WS_END = OFF_GATES + 2 * SZ_TOK1K;
constexpr size_t OFF_S = OFF_H1, OFF_XIN = OFF_H1 + (size_t)NCH * 32 * 256 * 4;
static_assert(OFF_XIN + (size_t)NCH * 32 * 256 * 2 <= OFF_Q, "h1 region overflow");
static_assert(WS_END <= (size_t)512 * 1024 * 1024, "workspace too large");
static_assert((size_t)HALF_TOK * DFF * 2 <= WS_END - OFF_Q, "act does not fit");
static_assert(OFF_H1 % 256 == 0, "align");

struct Params {
  const float* x[2];
  const float* c[2];
  const float *w_ada, *b_ada, *g_pre_mix, *g_post_mix, *g_pre_ffn, *g_post_ffn, *w_in, *lam_q1, *lam_k1, *lam_q2, *lam_k2, *g_head;
  const float *lam_re[2], *lam_im[2], *log_step[2], *c_re[2], *c_im[2];
  const float *b_re, *b_im, *ssm_d, *w_glu, *b_glu, *w_pa, *w_ps, *w_out, *w_ff1, *w_ff2;
  float* out;
  char* ws;
};

DI int tidx() { int t = threadIdx.x; asm volatile("" : "+v"(t)); return t; }
DI int bidx() { int b = blockIdx.x; asm volatile("" : "+s"(b)); return b; }
DI unsigned pack_bf16(float a, float b) { f2_t v = {a, b}; bf2_t r = __builtin_convertvector(v, bf2_t); return __builtin_bit_cast(unsigned, r); }
DI float bf_lo(unsigned u) { return __uint_as_float(u << 16); }
DI float bf_hi(unsigned u) { return __uint_as_float(u & 0xffff0000u); }
DI float fast_exp(float x) { return __builtin_amdgcn_exp2f(x * 1.44269504089f); }
DI float sigmoidf_(float z) { return 1.0f / (1.0f + fast_exp(-z)); }
DI float gelu_tanh(float y) {
  const float z = 0.7978845608028654f * (y + 0.044715f * y * y * y);
  const float e = fast_exp(2.0f * z);
  const float th = 1.0f - 2.0f / (e + 1.0f);
  return 0.5f * y * (1.0f + th);
}
DI float xhalf_max(float v) {
  const auto r = __builtin_amdgcn_permlane32_swap(__float_as_uint(v), __float_as_uint(v), false, false);
  return fmaxf(__uint_as_float(r[0]), __uint_as_float(r[1]));
}
DI float xhalf_sum(float v) {
  const auto r = __builtin_amdgcn_permlane32_swap(__float_as_uint(v), __float_as_uint(v), false, false);
  return __uint_as_float(r[0]) + __uint_as_float(r[1]);
}
DI float wave_sum(float v) {
#pragma unroll
  for (int o = 32; o >= 1; o >>= 1) v += __shfl_xor(v, o);
  return v;
}

constexpr int RS_G = 144;
constexpr int G_STAGE = (256 + 256) * RS_G;
constexpr int LDS_BYTES = 151552;
static_assert(2 * G_STAGE <= LDS_BYTES, "lds");
typedef f32x16 acc_t[2][4];

#define G_RAW_BARRIER() do { asm volatile("s_waitcnt lgkmcnt(0)" ::: "memory"); __builtin_amdgcn_s_barrier(); } while (0)
constexpr int GD_STAGE = 65536;
static_assert(2 * GD_STAGE <= LDS_BYTES, "lds");
template <class XF>
DI void gemm_main(acc_t& acc, const XF& xf, const bf16_t* __restrict__ W, int ldw, int nk, char* lds) {
  const int tid = tidx(), lane = tid & 63, wave = __builtin_amdgcn_readfirstlane(tid >> 6);
  const int lq = lane & 31, hi = lane >> 5, wt = wave & 1, wn = wave >> 1;
  const int drow = wave * 8 + (lane >> 3), dcp = lane & 7;
  auto dma_step = [&](int kt, int stage) {
    char* st = lds + stage * GD_STAGE + wave * 1024;
#pragma unroll
    for (int i = 0; i < 4; ++i) {
      const int row = i * 64 + drow;
      const int c = dcp ^ ((row >> 1) & 7);
      __builtin_amdgcn_global_load_lds((const unsigned*)xf(row, kt * 8 + c), (LDS3 unsigned*)(st + i * 8192), 16, 0, 0);
    }
#pragma unroll
    for (int i = 0; i < 4; ++i) {
      const int row = i * 64 + drow;
      const int c = dcp ^ ((row >> 1) & 7);
      __builtin_amdgcn_global_load_lds((const unsigned*)(W + (size_t)row * ldw + (kt * 8 + c) * 8), (LDS3 unsigned*)(st + 32768 + i * 8192), 16, 0, 0);
    }
  };
  __syncthreads();
  dma_step(0, 0);
  asm volatile("s_waitcnt vmcnt(0)" ::: "memory");
  G_RAW_BARRIER();
  const int swz = (lq >> 1) & 7;
  const int xrow = (wt * 128 + lq) * 128, wrow = 32768 + (wn * 64 + lq) * 128;
  for (int kt = 0; kt < nk; ++kt) {
    if (kt + 1 < nk) dma_step(kt + 1, (kt + 1) & 1);
    const int sb = (kt & 1) * GD_STAGE;
#define GSB() __builtin_amdgcn_sched_barrier(0)
#define LOADF(f, ks)                                                                                   \
  {                                                                                                    \
    int co = (((ks) * 2 + hi) ^ swz) * 16;                                                             \
    int xo = sb + xrow + co, wo = sb + wrow + co;                                                      \
    asm volatile("" : "+v"(xo)); asm volatile("" : "+v"(wo));                                          \
    const LDS3 char* Xs = (LDS3 char*)lds + xo; const LDS3 char* Ws = (LDS3 char*)lds + wo;            \
    f[0] = *(const LDS3 bf16x8*)(Ws); f[1] = *(const LDS3 bf16x8*)(Ws + 4096);                         \
    f[2] = *(const LDS3 bf16x8*)(Xs); f[3] = *(const LDS3 bf16x8*)(Xs + 4096);                         \
    f[4] = *(const LDS3 bf16x8*)(Xs + 8192); f[5] = *(const LDS3 bf16x8*)(Xs + 12288);                 \
  }
#define MM(f)                                                                                          \
  acc[0][0] = MFMA32(f[0], f[2], acc[0][0]); acc[1][0] = MFMA32(f[1], f[2], acc[1][0]);                \
  acc[0][1] = MFMA32(f[0], f[3], acc[0][1]); acc[1][1] = MFMA32(f[1], f[3], acc[1][1]);                \
  acc[0][2] = MFMA32(f[0], f[4], acc[0][2]); acc[1][2] = MFMA32(f[1], f[4], acc[1][2]);                \
  acc[0][3] = MFMA32(f[0], f[5], acc[0][3]); acc[1][3] = MFMA32(f[1], f[5], acc[1][3]);
    {
      bf16x8 fa[6], fb[6];
      GSB();
      LOADF(fa, 0) GSB();
      LOADF(fb, 1) GSB(); MM(fa) GSB();
      LOADF(fa, 2) GSB(); MM(fb) GSB();
      LOADF(fb, 3) GSB(); MM(fa) GSB();
      MM(fb) GSB();
    }
#undef GSB
#undef LOADF
#undef MM
    asm volatile("s_waitcnt vmcnt(0)" ::: "memory");
    G_RAW_BARRIER();
  }
}

DI void zero_acc(acc_t& acc) {
#pragma unroll
  for (int a = 0; a < 2; ++a)
#pragma unroll
    for (int b = 0; b < 4; ++b)
#pragma unroll
      for (int i = 0; i < 16; ++i) acc[a][b][i] = 0.f;
}

struct XPlain {
  const bf16_t* base; int ld;
  DI const uint4* operator()(int row, int kc) const { return (const uint4*)(base + (size_t)row * ld + kc * 8); }
};
struct XSsm {
  const bf16_t* ubase;
  const bf16_t* xin;
  DI const uint4* operator()(int row, int kc) const {
    if (kc < 64) return (const uint4*)(ubase + (size_t)(row * 32 + (kc >> 1)) * 512 + (kc & 1) * 8);
    return (const uint4*)(xin + (size_t)row * (32 * 256) + (kc - 64) * 8);
  }
};

template <class F>
DI void epi_iter(const acc_t& acc, F f) {
  const int lane = tidx() & 63, wave = tidx() >> 6;
  const int lq = lane & 31, hi = lane >> 5, wt = wave & 1, wn = wave >> 1;
#pragma unroll
  for (int nb = 0; nb < 2; ++nb)
#pragma unroll
    for (int tb = 0; tb < 4; ++tb)
#pragma unroll
      for (int gi = 0; gi < 4; ++gi)
        f(wt * 128 + tb * 32 + lq, wn * 64 + nb * 32 + gi * 8 + hi * 4, acc[nb][tb][gi * 4 + 0], acc[nb][tb][gi * 4 + 1],
          acc[nb][tb][gi * 4 + 2], acc[nb][tb][gi * 4 + 3]);
}
DI void store_bf4(bf16_t* p, float a, float b, float c, float d) {
  uint2 v; v.x = pack_bf16(a, b); v.y = pack_bf16(c, d);
  *(uint2*)p = v;
}

DI void transpose_tile(const float* __restrict__ W, bf16_t* __restrict__ Wt, int K, int N, int kt, int nt, char* lds) {
  float (*t)[65] = (float (*)[65])lds;
  const int tid = tidx();
  const int c = tid & 63, r0 = tid >> 6;
  __syncthreads();
#pragma unroll
  for (int i = 0; i < 8; ++i) { const int k = r0 + 8 * i; t[k][c] = W[(size_t)(kt * 64 + k) * N + nt * 64 + c]; }
  __syncthreads();
  const int kk = (tid & 31) * 2, nn = tid >> 5;
#pragma unroll
  for (int i = 0; i < 4; ++i) {
    const int n = nn + 16 * i;
    *(unsigned*)(Wt + (size_t)(nt * 64 + n) * K + kt * 64 + kk) = pack_bf16(t[kk][n], t[kk + 1][n]);
  }
}

DI void sincos_rev(double ang, float& s, float& c) {
  double r = ang * 0.15915494309189533577;
  r -= rint(r);
  const float fr = (float)r;
  s = __builtin_amdgcn_sinf(fr);
  c = __builtin_amdgcn_cosf(fr);
}

DI void ssm_tables(const Params& p, int g, int dir, char* lds) {
  float2 (*Apow)[64] = (float2 (*)[64])lds;
  float2 (*Bb)[16] = (float2 (*)[16])(lds + 33 * 64 * 8);
  float2 (*Cc)[64] = (float2 (*)[64])(lds + 33 * 64 * 8 + 64 * 16 * 8);
  float2* cz = (float2*)(lds + 33 * 64 * 8 + 2 * 64 * 16 * 8);
  const int tid = tidx();
  __syncthreads();
  const double step = exp((double)p.log_step[dir][g]);
  if (tid < 64) {
    const int n = tid;
    const double lre = (double)p.lam_re[dir][g * 64 + n], lim = (double)p.lam_im[dir][g * 64 + n];
#pragma nounroll
    for (int tau = 0; tau <= 32; ++tau) {
      float s, c; sincos_rev(lim * step * tau, s, c);
      const float mag = (float)exp(lre * step * tau);
      Apow[tau][n] = make_float2(mag * c, mag * s);
    }
    double sd, cd; sincos(lim * step, &sd, &cd);
    const double ea = exp(lre * step);
    const double ar = ea * cd, ai = ea * sd, nr = ar - 1.0, den = lre * lre + lim * lim;
    cz[n] = make_float2((float)((nr * lre + ai * lim) / den), (float)((ai * lre - nr * lim) / den));
  }
  __syncthreads();
  for (int e = tid; e < 1024; e += NT) {
    const int n = e >> 4, q = e & 15;
    const float br = p.b_re[(g * 64 + n) * 16 + q], bi = p.b_im[(g * 64 + n) * 16 + q];
    const float2 z = cz[n];
    Bb[n][q] = make_float2(z.x * br - z.y * bi, z.x * bi + z.y * br);
    const int pp = e >> 6, nn = e & 63;
    Cc[pp][nn] = make_float2(p.c_re[dir][(g * 16 + pp) * 64 + nn], p.c_im[dir][(g * 16 + pp) * 64 + nn]);
  }
  __syncthreads();
  float* ktab = (float*)(p.ws + OFF_KTAB) + (size_t)(g * 2 + dir) * 32 * 256;
  for (int e = tid; e < 32 * 256; e += NT) {
    const int tau = e >> 8, pp = (e >> 4) & 15, q = e & 15;
    float acc = 0.f;
#pragma unroll 4
    for (int n = 0; n < 64; ++n) {
      const float2 a = Apow[tau][n], cc = Cc[pp][n], b = Bb[n][q];
      const float gr = cc.x * a.x - cc.y * a.y, gi = cc.x * a.y + cc.y * a.x;
      acc += gr * b.x - gi * b.y;
    }
    ktab[e] = acc;
  }
  bf16_t* wend = (bf16_t*)(p.ws + OFF_WEND) + (size_t)g * 256 * 512 + (size_t)dir * 128 * 512;
  for (int e = tid; e < 128 * 256; e += NT) {
    const int row = e >> 8, k = (e & 255) * 2;
    const int n = row >> 1, ri = row & 1, t = k >> 4, pp = k & 15;
    const float2 a = Apow[dir == 0 ? 31 - t : t][n];
    const float2 b0 = Bb[n][pp], b1 = Bb[n][pp + 1];
    const float v0 = ri == 0 ? (a.x * b0.x - a.y * b0.y) : (a.x * b0.y + a.y * b0.x);
    const float v1 = ri == 0 ? (a.x * b1.x - a.y * b1.y) : (a.x * b1.y + a.y * b1.x);
    *(unsigned*)(wend + (size_t)row * 512 + k) = pack_bf16(v0, v1);
  }
  bf16_t* wt = (bf16_t*)(p.ws + OFF_WTOEP) + (size_t)g * 512 * 768 + 512 + dir * 128;
  for (int e = tid; e < 512 * 64; e += NT) {
    const int row = e >> 6, n = e & 63, t = row >> 4, pp = row & 15;
    const float2 a = Apow[dir == 0 ? t + 1 : 32 - t][n], cc = Cc[pp][n];
    const float gr = cc.x * a.x - cc.y * a.y, gi = cc.x * a.y + cc.y * a.x;
    *(unsigned*)(wt + (size_t)row * 768 + n * 2) = pack_bf16(gr, -gi);
  }
}

DI void mod_item(const Params& p, int j, char* lds) {
  float (*sc)[1024] = (float (*)[1024])lds;
  float* red = (float*)(lds + 6 * 1024 * 4);
  const int tid = tidx();
  __syncthreads();
  for (int e = tid; e < 6144; e += NT) {
    const int b = e >> 10, k = e & 1023;
    const float v = b < 2 ? p.c[0][b * 1024 + k] : p.c[1][(b - 2) * 1024 + k];
    sc[b][k] = v * sigmoidf_(v);
  }
  __syncthreads();
  const int col = tid & 31, kq = tid >> 5;
  if (col < 24) {
    float a[6] = {0.f, 0.f, 0.f, 0.f, 0.f, 0.f};
#pragma unroll 4
    for (int k = kq; k < 1024; k += 16) {
      const float w = p.w_ada[(size_t)k * 6144 + j * 24 + col];
#pragma unroll
      for (int b = 0; b < 6; ++b) a[b] += sc[b][k] * w;
    }
#pragma unroll
    for (int b = 0; b < 6; ++b) red[(kq * 6 + b) * 24 + col] = a[b];
  }
  __syncthreads();
  if (tid < 144) {
    const int b = tid / 24, c2 = tid % 24;
    float s = p.b_ada[j * 24 + c2];
    for (int q = 0; q < 16; ++q) s += red[(q * 6 + b) * 24 + c2];
    ((float*)(p.ws + OFF_MOD))[b * 6144 + j * 24 + c2] = s;
  }
}

DI void phase0a(const Params& p, char* lds) {
  const int tid = tidx();
  constexpr int N_SSM = 64, N_MOD = 256, N_ROPE = 32, N_LAM = 1;
  constexpr int T_WIN = 16 * 88, T_WPA = 16 * 16, T_WPS = 8 * 16, T_WGLU = 8 * 8, T_WOUT = 16 * 16, T_FF1 = 16 * 64, T_FF2 = 64 * 16;
  constexpr int B0 = N_SSM + N_MOD + N_ROPE + N_LAM;
  constexpr int NITEMS = B0 + T_WIN + T_WPA + T_WPS + T_WGLU + T_WOUT + T_FF1 + T_FF2;
  for (int it = bidx(); it < NITEMS; it += gridDim.x) {
    if (it < N_SSM) { ssm_tables(p, it >> 1, it & 1, lds); continue; }
    int i = it - N_SSM;
    if (i < N_MOD) { mod_item(p, i, lds); continue; }
    i -= N_MOD;
    if (i < N_ROPE) {
      float2* rope = (float2*)(p.ws + OFF_ROPE);
      for (int e = tid; e < 4096; e += NT) {
        const int pos = i * 512 + (e >> 3), f = e & 7;
        const double invf = exp2(-(double)f * 0.125 * 18.931568569324174);
        float s, c; sincos_rev((double)pos * invf, s, c);
        rope[pos * 8 + f] = make_float2(c, s);
      }
      continue;
    }
    i -= N_ROPE;
    if (i < N_LAM) {
      if (tid == 0) {
        float s1 = 0.f, s2 = 0.f;
        for (int k = 0; k < 64; ++k) { s1 += p.lam_q1[k] * p.lam_k1[k]; s2 += p.lam_q2[k] * p.lam_k2[k]; }
        ((float*)(p.ws + OFF_SCAL))[0] = expf(s1) - expf(s2) + 0.2f;
      }
      continue;
    }
    i -= N_LAM;
    if (i < T_WIN) { transpose_tile(p.w_in, (bf16_t*)(p.ws + OFF_WIN), 1024, INW, i / 88, i % 88, lds); continue; }
    i -= T_WIN;
    if (i < T_WPA) { transpose_tile(p.w_pa, (bf16_t*)(p.ws + OFF_WPA), 1024, 1024, i / 16, i % 16, lds); continue; }
    i -= T_WPA;
    if (i < T_WPS) { transpose_tile(p.w_ps, (bf16_t*)(p.ws + OFF_WPS), 512, 1024, i / 16, i % 16, lds); continue; }
    i -= T_WPS;
    if (i < T_WGLU) { transpose_tile(p.w_glu, (bf16_t*)(p.ws + OFF_WGLU), 512, 512, i / 8, i % 8, lds); continue; }
    i -= T_WGLU;
    if (i < T_WOUT) { transpose_tile(p.w_out, (bf16_t*)(p.ws + OFF_WOUT), 1024, 1024, i / 16, i % 16, lds); continue; }
    i -= T_WOUT;
    if (i < T_FF1) { transpose_tile(p.w_ff1, (bf16_t*)(p.ws + OFF_WFF1), 1024, 4096, i / 64, i % 64, lds); continue; }
    i -= T_FF1;
    transpose_tile(p.w_ff2, (bf16_t*)(p.ws + OFF_WFF2), 4096, 1024, i / 16, i % 16, lds);
  }
}

DI void phase0b(const Params& p) {
  const int tid = tidx();
  const float* ktab = (const float*)(p.ws + OFF_KTAB);
  for (int it = bidx(); it < 32 * 16; it += gridDim.x) {
    const int g = it >> 4, rb = it & 15;
    bf16_t* wt = (bf16_t*)(p.ws + OFF_WTOEP) + (size_t)g * 512 * 768;
    const float* kf = ktab + (size_t)(g * 2 + 0) * 32 * 256;
    const float* kb = ktab + (size_t)(g * 2 + 1) * 32 * 256;
    for (int e = tid; e < 32 * 256; e += NT) {
      const int row = rb * 32 + (e >> 8), k = (e & 255) * 2;
      const int t = row >> 4, pp = row & 15, s = k >> 4, q = k & 15;
      float v0 = 0.f, v1 = 0.f;
      if (t >= s) { v0 += kf[(t - s) * 256 + pp * 16 + q]; v1 += kf[(t - s) * 256 + pp * 16 + q + 1]; }
      if (s >= t) { v0 += kb[(s - t) * 256 + pp * 16 + q]; v1 += kb[(s - t) * 256 + pp * 16 + q + 1]; }
      *(unsigned*)(wt + (size_t)row * 768 + k) = pack_bf16(v0, v1);
    }
  }
}

DI void load_row16(const float* r, int lane, float (&v)[16]) {
#pragma unroll
  for (int j = 0; j < 4; ++j) { const float4 t = *(const float4*)(r + j * 256 + lane * 4); v[j * 4] = t.x; v[j * 4 + 1] = t.y; v[j * 4 + 2] = t.z; v[j * 4 + 3] = t.w; }
}
DI void load_row16_bf(const bf16_t* r, int lane, float (&v)[16]) {
#pragma unroll
  for (int j = 0; j < 4; ++j) { const uint2 t = *(const uint2*)(r + j * 256 + lane * 4); v[j * 4] = bf_lo(t.x); v[j * 4 + 1] = bf_hi(t.x); v[j * 4 + 2] = bf_lo(t.y); v[j * 4 + 3] = bf_hi(t.y); }
}

DI void modnorm_store(const float (&x)[16], int lane, const float* g, const float* sc, const float* sh, bf16_t* dst) {
  float ss = 0.f;
#pragma unroll
  for (int i = 0; i < 16; ++i) ss += x[i] * x[i];
  ss = wave_sum(ss);
  const float rstd = rsqrtf(ss * (1.0f / 1024.0f) + 1e-6f);
#pragma unroll
  for (int j = 0; j < 4; ++j) {
    const int c = j * 256 + lane * 4;
    const float4 gg = *(const float4*)(g + c), s1 = *(const float4*)(sc + c), s0 = *(const float4*)(sh + c);
    store_bf4(dst + c, x[j * 4] * rstd * gg.x * (1.f + s1.x) + s0.x, x[j * 4 + 1] * rstd * gg.y * (1.f + s1.y) + s0.y,
              x[j * 4 + 2] * rstd * gg.z * (1.f + s1.z) + s0.z, x[j * 4 + 3] * rstd * gg.w * (1.f + s1.w) + s0.w);
  }
}

DI void phase_h1(const Params& p, int hf) {
  if (bidx() == 0 && tidx() < 64) ((float*)(p.ws + OFF_KMAX))[tidx()] = 0.f;
  const int lane = tidx() & 63, gw = bidx() * 8 + (tidx() >> 6), nw = gridDim.x * 8;
  const int lsh = hf == 0 ? 14 : 13;
  const float* mod = (const float*)(p.ws + OFF_MOD);
  bf16_t* h1 = (bf16_t*)(p.ws + OFF_H1);
  for (int row = gw; row < HALF_TOK; row += nw) {
    const int b = (hf == 0 ? 0 : 2) + (row >> lsh);
    float x[16]; load_row16(p.x[hf] + (size_t)row * 1024, lane, x);
    modnorm_store(x, lane, p.g_pre_mix, mod + b * 6144 + 1024, mod + b * 6144, h1 + (size_t)row * 1024);
  }
}

DI void phase_x1(const Params& p, int hf) {
  const int lane = tidx() & 63, gw = bidx() * 8 + (tidx() >> 6), nw = gridDim.x * 8;
  const int lsh = hf == 0 ? 14 : 13;
  const float* mod = (const float*)(p.ws + OFF_MOD);
  const bf16_t* mix = (const bf16_t*)(p.ws + OFF_V);
  bf16_t* h2 = (bf16_t*)(p.ws + OFF_H1);
  float* outp = p.out + (size_t)hf * HALF_TOK * 1024;
  for (int row = gw; row < HALF_TOK; row += nw) {
    const int b = (hf == 0 ? 0 : 2) + (row >> lsh);
    const float* mb = mod + b * 6144;
    float x[16], m[16];
    load_row16(p.x[hf] + (size_t)row * 1024, lane, x);
    load_row16_bf(mix + (size_t)row * 1024, lane, m);
    float ss = 0.f;
#pragma unroll
    for (int i = 0; i < 16; ++i) ss += m[i] * m[i];
    ss = wave_sum(ss);
    const float rstd = rsqrtf(ss * (1.0f / 1024.0f) + 1e-6f);
#pragma unroll
    for (int j = 0; j < 4; ++j) {
      const int c = j * 256 + lane * 4;
      const float4 gg = *(const float4*)(p.g_post_mix + c), gt = *(const float4*)(mb + 2048 + c);
      x[j * 4] += gt.x * m[j * 4] * rstd * gg.x; x[j * 4 + 1] += gt.y * m[j * 4 + 1] * rstd * gg.y;
      x[j * 4 + 2] += gt.z * m[j * 4 + 2] * rstd * gg.z; x[j * 4 + 3] += gt.w * m[j * 4 + 3] * rstd * gg.w;
      *(float4*)(outp + (size_t)row * 1024 + c) = make_float4(x[j * 4], x[j * 4 + 1], x[j * 4 + 2], x[j * 4 + 3]);
    }
    modnorm_store(x, lane, p.g_pre_ffn, mb + 4096, mb + 3072, h2 + (size_t)row * 1024);
  }
}

DI void phase_final(const Params& p, int hf) {
  const int lane = tidx() & 63, gw = bidx() * 8 + (tidx() >> 6), nw = gridDim.x * 8;
  const int lsh = hf == 0 ? 14 : 13;
  const float* mod = (const float*)(p.ws + OFF_MOD);
  const bf16_t* fb = (const bf16_t*)(p.ws + OFF_H1);
  float* outp = p.out + (size_t)hf * HALF_TOK * 1024;
  for (int row = gw; row < HALF_TOK; row += nw) {
    const int b = (hf == 0 ? 0 : 2) + (row >> lsh);
    const float* mb = mod + b * 6144;
    float x[16], m[16];
    load_row16(outp + (size_t)row * 1024, lane, x);
    load_row16_bf(fb + (size_t)row * 1024, lane, m);
    float ss = 0.f;
#pragma unroll
    for (int i = 0; i < 16; ++i) ss += m[i] * m[i];
    ss = wave_sum(ss);
    const float rstd = rsqrtf(ss * (1.0f / 1024.0f) + 1e-6f);
#pragma unroll
    for (int j = 0; j < 4; ++j) {
      const int c = j * 256 + lane * 4;
      const float4 gg = *(const float4*)(p.g_post_ffn + c), gt = *(const float4*)(mb + 5120 + c);
      *(float4*)(outp + (size_t)row * 1024 + c) =
          make_float4(x[j * 4] + gt.x * m[j * 4] * rstd * gg.x, x[j * 4 + 1] + gt.y * m[j * 4 + 1] * rstd * gg.y,
                      x[j * 4 + 2] + gt.z * m[j * 4 + 2] * rstd * gg.z, x[j * 4 + 3] + gt.w * m[j * 4 + 3] * rstd * gg.w);
    }
  }
}

DI void ssm_scan_job(const Params& p, int hf, int job, char* lds) {
  const int lane = tidx() & 63, wave = __builtin_amdgcn_readfirstlane(tidx() >> 6);
  const int nc = hf == 0 ? 512 : 256;
  const int len = nc >> 3;
  const int b = job >> 6, g = (job >> 1) & 31, dir = job & 1, n = lane;
  const double step = exp((double)p.log_step[dir][g]);
  const double lre = (double)p.lam_re[dir][g * 64 + n], lim = (double)p.lam_im[dir][g * 64 + n];
  float s, c; sincos_rev(lim * step * (double)TCH, s, c);
  const float mag = (float)exp(lre * step * (double)TCH);
  const float ar = mag * c, ai = mag * s;
  float s2, c2; sincos_rev(lim * step * (double)(TCH * len), s2, c2);
  const float mag2 = (float)exp(lre * step * (double)(TCH * len));
  const float pr = mag2 * c2, pi = mag2 * s2;
  const float* S = (const float*)(p.ws + OFF_S) + ((size_t)(b * nc) * 32 + g) * 256 + dir * 128 + n * 2;
  unsigned* X = (unsigned*)((bf16_t*)(p.ws + OFF_XIN) + ((size_t)(b * nc) * 32 + g) * 256 + dir * 128 + n * 2);
  const int c0 = dir == 0 ? 0 : nc - 1;
  const long cs = dir == 0 ? 1 : -1;
  const int i0 = wave * len;
  float2* E = (float2*)lds;
  __syncthreads();
  float xr = 0.f, xi = 0.f;
  for (int cb = i0; cb < i0 + len; cb += 16) {
    float2 sv[16];
#pragma unroll
    for (int j = 0; j < 16; ++j) sv[j] = *(const float2*)(S + (size_t)(c0 + cs * (cb + j)) * (32 * 256));
#pragma unroll
    for (int j = 0; j < 16; ++j) {
      const float nr = ar * xr - ai * xi + sv[j].x, ni = ar * xi + ai * xr + sv[j].y;
      xr = nr; xi = ni;
    }
  }
  E[wave * 64 + lane] = make_float2(xr, xi);
  __syncthreads();
  xr = 0.f; xi = 0.f;
  for (int v = 0; v < wave; ++v) {
    const float2 e = E[v * 64 + lane];
    const float nr = pr * xr - pi * xi + e.x, ni = pr * xi + pi * xr + e.y;
    xr = nr; xi = ni;
  }
  for (int cb = i0; cb < i0 + len; cb += 16) {
    float2 sv[16];
#pragma unroll
    for (int j = 0; j < 16; ++j) sv[j] = *(const float2*)(S + (size_t)(c0 + cs * (cb + j)) * (32 * 256));
#pragma unroll
    for (int j = 0; j < 16; ++j) {
      X[(size_t)(c0 + cs * (cb + j)) * (32 * 256 / 2)] = pack_bf16(xr, xi);
      const float nr = ar * xr - ai * xi + sv[j].x, ni = ar * xi + ai * xr + sv[j].y;
      xr = nr; xi = ni;
    }
  }
}

typedef float f32x4v __attribute__((ext_vector_type(4)));
typedef f32x4v acc8_t[2][2][4][2];
constexpr int P8_HB = 128 * 64 * 2;
static_assert(8 * P8_HB <= LDS_BYTES, "lds");
DI int p8_lds_byte(int r, int c) { const int st = (r >> 4) * 2 + (c >> 5), rr = r & 15, cc = c & 31, ob = rr * 64 + cc * 2; return st * 1024 + (ob ^ (((ob >> 9) & 1) << 5)); }
DI void p8_stage_rc(int b, int& R, int& C) { const int st = b / 1024, sb = b % 1024, swz = sb ^ (((sb >> 9) & 1) << 5); R = (st >> 1) * 16 + swz / 64; C = (st & 1) * 32 + (swz % 64) / 2; }

template <int XMODE = 0>
DI void gemm_main8(acc8_t& acc, const bf16_t* __restrict__ Wt, int ldw, const bf16_t* __restrict__ Xt, int ldx, int nt, char* lds,
                   const bf16_t* __restrict__ X2 = nullptr) {
  const int tid = tidx(), wid = __builtin_amdgcn_readfirstlane(tid >> 6), lane = tid & 63;
  const int wr = wid >> 2, wc = wid & 3, fr = lane & 15, fq = lane >> 4;
#define P8SA(b, h) (lds + ((b) * 2 + (h)) * P8_HB)
#define P8SB(b, h) (lds + (4 + (b) * 2 + (h)) * P8_HB)
  int p8r0, p8c0; p8_stage_rc(tid * 16, p8r0, p8c0);
  const unsigned offA = (unsigned)(p8r0 * ldw + p8c0) * 2u;
  const unsigned offB = XMODE == 0 ? (unsigned)(p8r0 * ldx + p8c0) * 2u
                                   : (unsigned)(p8r0 * 16384 + (p8c0 >> 4) * 512 + ((p8c0 >> 3) & 1) * 8) * 2u;
  const unsigned offB2 = (unsigned)(p8r0 * 8192 + p8c0) * 2u;
#define P8STAGE_A(P, half, kt)                                                                                         \
  do {                                                                                                                 \
    _Pragma("unroll") for (int _i = 0; _i < 2; ++_i) {                                                                 \
      const char* _ub = (const char*)(Wt + (size_t)((half) * 128 + _i * 64) * ldw + (kt) * 64);                        \
      __builtin_amdgcn_global_load_lds((const unsigned*)(_ub + offA), (LDS3 unsigned*)((P) + tid * 16 + _i * 8192), 16, 0, 0); \
    }                                                                                                                  \
  } while (0)
#define P8STAGE_B(P, half, kt)                                                                                         \
  do {                                                                                                                 \
    _Pragma("unroll") for (int _i = 0; _i < 2; ++_i) {                                                                 \
      const int _rb = (half) * 128 + _i * 64;                                                                          \
      const char* _ub; unsigned _of;                                                                                   \
      if (XMODE == 0) { _ub = (const char*)(Xt + (size_t)_rb * ldx + (kt) * 64); _of = offB; }                          \
      else {                                                                                                           \
        const bool _u = (kt) < 8;                                                                                      \
        _ub = _u ? (const char*)(Xt + (size_t)_rb * 16384 + (kt) * 2048) : (const char*)(X2 + (size_t)_rb * 8192 + ((kt) - 8) * 64); \
        _of = _u ? offB : offB2;                                                                                       \
      }                                                                                                                \
      __builtin_amdgcn_global_load_lds((const unsigned*)(_ub + _of), (LDS3 unsigned*)((P) + tid * 16 + _i * 8192), 16, 0, 0); \
    }                                                                                                                  \
  } while (0)
#define P8LDA(dst, b, h)                                                                                               \
  _Pragma("unroll") for (int m = 0; m < 4; ++m) _Pragma("unroll") for (int k = 0; k < 2; ++k)                          \
    dst[m][k] = *reinterpret_cast<const bf16x8*>(P8SA(b, h) + p8_lds_byte(wr * 64 + m * 16 + fr, k * 32 + fq * 8))
#define P8LDB(dst, b, h)                                                                                               \
  _Pragma("unroll") for (int n = 0; n < 2; ++n) _Pragma("unroll") for (int k = 0; k < 2; ++k)                          \
    dst[n][k] = *reinterpret_cast<const bf16x8*>(P8SB(b, h) + p8_lds_byte(wc * 32 + n * 16 + fr, k * 32 + fq * 8))
#define P8MMA(ai, bj, A_, B_)                                                                                          \
  do {                                                                                                                 \
    __builtin_amdgcn_s_setprio(1);                                                                                     \
    _Pragma("unroll") for (int m = 0; m < 4; ++m) _Pragma("unroll") for (int n = 0; n < 2; ++n)                        \
      _Pragma("unroll") for (int k = 0; k < 2; ++k)                                                                    \
        acc[ai][bj][m][n] = __builtin_amdgcn_mfma_f32_16x16x32_bf16(A_[m][k], B_[n][k], acc[ai][bj][m][n], 0, 0, 0);   \
    __builtin_amdgcn_s_setprio(0);                                                                                     \
  } while (0)
#define P8WV(n) asm volatile("s_waitcnt vmcnt(" #n ")" ::: "memory")
#define P8WL(n) asm volatile("s_waitcnt lgkmcnt(" #n ")" ::: "memory")
#define P8BAR __builtin_amdgcn_s_barrier()
#define P8SCHED __builtin_amdgcn_sched_barrier(0)
  bf16x8 At[4][2], B0[2][2], B1[2][2];
  P8STAGE_B(P8SB(0, 0), 0, 0); P8STAGE_A(P8SA(0, 0), 0, 0);
  P8STAGE_B(P8SB(0, 1), 1, 0); P8STAGE_A(P8SA(0, 1), 1, 0);
  if (wr == 1) P8BAR;
  P8WV(4); P8BAR;
  P8STAGE_B(P8SB(1, 0), 0, 1); P8STAGE_A(P8SA(1, 0), 0, 1); P8STAGE_B(P8SB(1, 1), 1, 1);
  P8WV(6); P8BAR;
#pragma nounroll
  for (int t = 0; t < nt - 2; t += 2) {
    P8LDB(B0, 0, 0); P8SCHED; P8LDA(At, 0, 0); P8STAGE_A(P8SA(1, 1), 1, t + 1);
    P8WL(8); P8BAR; P8WL(0); P8MMA(0, 0, At, B0); P8BAR; P8SCHED;
    P8LDB(B1, 0, 1); P8STAGE_B(P8SB(0, 0), 0, t + 2);
    P8BAR; P8WL(0); P8MMA(0, 1, At, B1); P8BAR;
    P8LDA(At, 0, 1); P8STAGE_A(P8SA(0, 0), 0, t + 2);
    P8BAR; P8WL(0); P8MMA(1, 0, At, B0); P8BAR; P8SCHED;
    P8STAGE_B(P8SB(0, 1), 1, t + 2);
    P8WV(6); P8BAR; P8MMA(1, 1, At, B1); P8BAR;
    P8LDB(B0, 1, 0); P8SCHED; P8LDA(At, 1, 0); P8STAGE_A(P8SA(0, 1), 1, t + 2);
    P8WL(8); P8BAR; P8WL(0); P8MMA(0, 0, At, B0); P8BAR; P8SCHED;
    P8LDB(B1, 1, 1); P8STAGE_B(P8SB(1, 0), 0, t + 3);
    P8BAR; P8WL(0); P8MMA(0, 1, At, B1); P8BAR;
    P8LDA(At, 1, 1); P8STAGE_A(P8SA(1, 0), 0, t + 3);
    P8BAR; P8WL(0); P8MMA(1, 0, At, B0); P8BAR; P8SCHED;
    P8STAGE_B(P8SB(1, 1), 1, t + 3);
    P8WV(6); P8BAR; P8MMA(1, 1, At, B1); P8BAR;
  }
  { P8LDB(B0, 0, 0); P8LDA(At, 0, 0); P8STAGE_A(P8SA(1, 1), 1, nt - 1);
    P8BAR; P8WL(0); P8MMA(0, 0, At, B0); P8BAR;
    P8LDB(B1, 0, 1); P8BAR; P8WL(0); P8MMA(0, 1, At, B1); P8BAR;
    P8LDA(At, 0, 1); P8WV(4); P8BAR; P8WL(0); P8MMA(1, 0, At, B0); P8MMA(1, 1, At, B1); P8BAR; }
  { P8LDB(B0, 1, 0); P8LDA(At, 1, 0); P8WV(2); P8BAR; P8WL(0); P8MMA(0, 0, At, B0); P8BAR;
    P8LDB(B1, 1, 1); P8WV(0); P8BAR; P8WL(0); P8MMA(0, 1, At, B1); P8BAR;
    P8LDA(At, 1, 1); P8BAR; P8WL(0); P8MMA(1, 0, At, B0); P8MMA(1, 1, At, B1); P8BAR; }
  if (wr == 0) P8BAR;
#undef P8SA
#undef P8SB
#undef P8STAGE_A
#undef P8STAGE_B
#undef P8LDA
#undef P8LDB
#undef P8MMA
#undef P8WV
#undef P8WL
#undef P8BAR
#undef P8SCHED
}

DI void zero_acc8(acc8_t& acc) {
#pragma unroll
  for (int a = 0; a < 2; ++a)
#pragma unroll
    for (int b = 0; b < 2; ++b)
#pragma unroll
      for (int m = 0; m < 4; ++m)
#pragma unroll
        for (int q = 0; q < 2; ++q) acc[a][b][m][q] = f32x4v{0.f, 0.f, 0.f, 0.f};
}
template <class F>
DI void epi8_iter(const acc8_t& acc, F f) {
  const int lane = tidx() & 63, wid = tidx() >> 6, wr = wid >> 2, wc = wid & 3, fr = lane & 15, fq = lane >> 4;
#pragma unroll
  for (int ai = 0; ai < 2; ++ai)
#pragma unroll
    for (int bj = 0; bj < 2; ++bj)
#pragma unroll
      for (int m = 0; m < 4; ++m)
#pragma unroll
        for (int q = 0; q < 2; ++q)
          f(bj * 128 + wc * 32 + q * 16 + fr, ai * 128 + wr * 64 + m * 16 + fq * 4, acc[ai][bj][m][q][0], acc[ai][bj][m][q][1],
            acc[ai][bj][m][q][2], acc[ai][bj][m][q][3]);
}

DI void phase_ssm_states(const Params& p, char* lds) {
  const bf16_t* u = (const bf16_t*)(p.ws + OFF_U);
  float* S = (float*)(p.ws + OFF_S);
  __syncthreads();
  for (int it = bidx(); it < 32 * 4; it += gridDim.x) {
    const int g = it >> 2, ct = it & 3;
    acc8_t acc; zero_acc8(acc);
    asm volatile("s_waitcnt vmcnt(0)" ::: "memory");
    gemm_main8<1>(acc, (const bf16_t*)(p.ws + OFF_WEND) + (size_t)g * 256 * 512, 512, u + (size_t)(ct * 256 * 32) * 512 + g * 16, 0, 8, lds);
    epi8_iter(acc, [&](int t, int n, float a, float b, float c, float d) {
      *(float4*)(S + ((size_t)(ct * 256 + t) * 32 + g) * 256 + n) = make_float4(a, b, c, d);
    });
  }
}

DI void phase_ssm_out(const Params& p, char* lds) {
  const bf16_t* u = (const bf16_t*)(p.ws + OFF_U);
  const bf16_t* xin = (const bf16_t*)(p.ws + OFF_XIN);
  bf16_t* yg = (bf16_t*)(p.ws + OFF_S);
  __syncthreads();
  for (int it = bidx(); it < 32 * 4 * 2; it += gridDim.x) {
    const int g = it >> 3, ct = (it >> 1) & 3, nt = it & 1;
    acc8_t acc; zero_acc8(acc);
    asm volatile("s_waitcnt vmcnt(0)" ::: "memory");
    gemm_main8<1>(acc, (const bf16_t*)(p.ws + OFF_WTOEP) + (size_t)g * 512 * 768 + (size_t)nt * 256 * 768, 768,
                  u + (size_t)(ct * 256 * 32) * 512 + g * 16, 0, 12, lds, xin + ((size_t)(ct * 256) * 32 + g) * 256);
    epi8_iter(acc, [&](int t, int n, float a, float b, float c, float d) {
      const int nn = nt * 256 + n, tt = nn >> 4, pp = nn & 15;
      const size_t tok = (size_t)(ct * 256 + t) * 32 + tt;
      const uint2 uu = *(const uint2*)(u + tok * 512 + g * 16 + pp);
      const float4 dd = *(const float4*)(p.ssm_d + g * 16 + pp);
      store_bf4(yg + tok * 512 + g * 16 + pp, gelu_tanh(a + dd.x * bf_lo(uu.x)), gelu_tanh(b + dd.y * bf_hi(uu.x)),
                gelu_tanh(c + dd.z * bf_lo(uu.y)), gelu_tanh(d + dd.w * bf_hi(uu.y)));
    });
  }
}

DI void phase_glu(const Params& p, char* lds) {
  const bf16_t* yg = (const bf16_t*)(p.ws + OFF_S);
  bf16_t* so = (bf16_t*)(p.ws + OFF_U);
  __syncthreads();
  for (int it = bidx(); it < 128 * 2; it += gridDim.x) {
    const int mt = it >> 1, nt = it & 1;
    acc8_t acc; zero_acc8(acc);
    asm volatile("s_waitcnt vmcnt(0)" ::: "memory");
    gemm_main8(acc, (const bf16_t*)(p.ws + OFF_WGLU) + (size_t)nt * 256 * 512, 512, yg + (size_t)mt * 256 * 512, 512, 8, lds);
    epi8_iter(acc, [&](int t, int n, float a, float b, float c, float d) {
      const size_t off = (size_t)(mt * 256 + t) * 512 + nt * 256 + n;
      const uint2 yy = *(const uint2*)(yg + off);
      const float4 bb = *(const float4*)(p.b_glu + nt * 256 + n);
      store_bf4(so + off, bf_lo(yy.x) * sigmoidf_(a + bb.x), bf_hi(yy.x) * sigmoidf_(b + bb.y), bf_lo(yy.y) * sigmoidf_(c + bb.z),
                bf_hi(yy.y) * sigmoidf_(d + bb.w));
    });
  }
}

DI void phase_merge(const Params& p, char* lds) {
  const bf16_t* at = (const bf16_t*)(p.ws + OFF_Q);
  const bf16_t* so = (const bf16_t*)(p.ws + OFF_U);
  const bf16_t* gates = (const bf16_t*)(p.ws + OFF_GATES);
  bf16_t* mg = (bf16_t*)(p.ws + OFF_K);
  __syncthreads();
  for (int it = bidx(); it < 128 * 4; it += gridDim.x) {
    const int r_ = it >> 8, w_ = it & 255;
    const int mt = 16 * (w_ & 7) + (r_ & 1) * 8 + (w_ >> 5), nt = (w_ >> 3) & 3;
    acc8_t acc; zero_acc8(acc);
    asm volatile("s_waitcnt vmcnt(0)" ::: "memory");
    gemm_main8(acc, (const bf16_t*)(p.ws + OFF_WPA) + (size_t)nt * 256 * 1024, 1024, at + (size_t)mt * 256 * 1024, 1024, 16, lds);
    epi8_iter(acc, [&](int t, int n, float a, float b, float c, float d) {
      const size_t tok = (size_t)mt * 256 + t;
      const int nn = nt * 256 + n;
      const uint2 ga = *(const uint2*)(gates + tok * 2048 + nn);
      store_bf4(mg + tok * 1024 + nn, bf_lo(ga.x) * a, bf_hi(ga.x) * b, bf_lo(ga.y) * c, bf_hi(ga.y) * d);
    });
    zero_acc8(acc);
    asm volatile("s_waitcnt vmcnt(0)" ::: "memory");
    gemm_main8(acc, (const bf16_t*)(p.ws + OFF_WPS) + (size_t)nt * 256 * 512, 512, so + (size_t)mt * 256 * 512, 512, 8, lds);
    epi8_iter(acc, [&](int t, int n, float a, float b, float c, float d) {
      const size_t tok = (size_t)mt * 256 + t;
      const int nn = nt * 256 + n;
      const uint2 gs = *(const uint2*)(gates + tok * 2048 + 1024 + nn);
      const uint2 pa = *(const uint2*)(mg + tok * 1024 + nn);
      store_bf4(mg + tok * 1024 + nn, bf_lo(pa.x) + bf_lo(gs.x) * a, bf_hi(pa.x) + bf_hi(gs.x) * b, bf_lo(pa.y) + bf_lo(gs.y) * c,
                bf_hi(pa.y) + bf_hi(gs.y) * d);
    });
  }
}

DI void phase_gemm_in(const Params& p, int hf, char* lds) {
  const bf16_t* h1 = (const bf16_t*)(p.ws + OFF_H1);
  const bf16_t* W = (const bf16_t*)(p.ws + OFF_WIN);
  const float2* rope = (const float2*)(p.ws + OFF_ROPE);
  const int lmask = (hf == 0 ? 16384 : 8192) - 1;
  constexpr int NTN = INW / 256;
  __syncthreads();
  for (int it = bidx(); it < 128 * NTN; it += gridDim.x) {
    const int mt = it / NTN, nt = it % NTN;
    acc8_t acc;
#pragma unroll
    for (int a = 0; a < 2; ++a)
#pragma unroll
      for (int b = 0; b < 2; ++b)
#pragma unroll
        for (int m = 0; m < 4; ++m)
#pragma unroll
          for (int q = 0; q < 2; ++q) acc[a][b][m][q] = f32x4v{0.f, 0.f, 0.f, 0.f};
    asm volatile("s_waitcnt vmcnt(0)" ::: "memory");
    gemm_main8(acc, W + (size_t)nt * 256 * 1024, 1024, h1 + (size_t)mt * 256 * 1024, 1024, 16, lds);
    const int lane = tidx() & 63, wid = tidx() >> 6, wr = wid >> 2, wc = wid & 3, fr = lane & 15, fq = lane >> 4;
    const int m0 = mt * 256;
#define EPI8(F)                                                                                                        \
  _Pragma("unroll") for (int ai = 0; ai < 2; ++ai) _Pragma("unroll") for (int bj = 0; bj < 2; ++bj)                    \
    _Pragma("unroll") for (int m = 0; m < 4; ++m) _Pragma("unroll") for (int q = 0; q < 2; ++q)                        \
      F(m0 + bj * 128 + wc * 32 + q * 16 + fr, ai * 128 + wr * 64 + m * 16 + fq * 4, acc[ai][bj][m][q][0],            \
        acc[ai][bj][m][q][1], acc[ai][bj][m][q][2], acc[ai][bj][m][q][3]);
    if (nt < 8) {
      const bool isq = nt < 4;
      bf16_t* dst = (bf16_t*)(p.ws + (isq ? OFF_Q : OFF_K)) + (nt & 3) * 256;
      const float qs = isq ? 0.125f * 1.44269504089f : 1.0f;
#pragma unroll
      for (int bj = 0; bj < 2; ++bj)
#pragma unroll
        for (int q = 0; q < 2; ++q) {
          const int pos = (m0 + bj * 128 + wc * 32 + q * 16 + fr) & lmask;
#pragma unroll
          for (int j = 0; j < 4; ++j) {
            const float2 cs = rope[pos * 8 + (fq & 1) * 4 + j];
#pragma unroll
            for (int ai = 0; ai < 2; ++ai) {
              const float v = acc[ai][bj][0][q][j];
              const float pv = __shfl_xor(v, 32);
              acc[ai][bj][0][q][j] = (fq < 2) ? v * cs.x - pv * cs.y : v * cs.x + pv * cs.y;
            }
          }
        }
      if (!isq) {
#pragma unroll
        for (int ai = 0; ai < 2; ++ai) {
          float kn2 = 0.f;
#pragma unroll
          for (int bj = 0; bj < 2; ++bj)
#pragma unroll
            for (int q = 0; q < 2; ++q) {
              float ss = 0.f;
#pragma unroll
              for (int m = 0; m < 4; ++m)
#pragma unroll
                for (int j = 0; j < 4; ++j) ss += acc[ai][bj][m][q][j] * acc[ai][bj][m][q][j];
              ss += __shfl_xor(ss, 16);
              ss += __shfl_xor(ss, 32);
              kn2 = fmaxf(kn2, ss);
            }
#pragma unroll
          for (int o = 8; o >= 1; o >>= 1) kn2 = fmaxf(kn2, __shfl_xor(kn2, o));
          if (lane == 0) {
            const int bb = m0 >> (hf == 0 ? 14 : 13), hd = (nt & 3) * 2 + ai;
            atomicMax((unsigned*)(p.ws + OFF_KMAX) + (bb * 8 + hd) * 2 + wr, __float_as_uint(kn2));
          }
        }
      }
#define ST_QK(t, n, a, b, c, d) store_bf4(dst + (size_t)(t) * 1024 + (n), (a) * qs, (b) * qs, (c) * qs, (d) * qs)
      EPI8(ST_QK)
#undef ST_QK
    } else if (nt < 12) {
      bf16_t* dst = (bf16_t*)(p.ws + OFF_V) + (nt - 8) * 256;
#define ST_V(t, n, a, b, c, d) store_bf4(dst + (size_t)(t) * 1024 + (n), a, b, c, d)
      EPI8(ST_V)
#undef ST_V
    } else if (nt < 14) {
      bf16_t* dst = (bf16_t*)(p.ws + OFF_U) + (nt - 12) * 256;
#define ST_U(t, n, a, b, c, d) store_bf4(dst + (size_t)(t) * 512 + (n), a, b, c, d)
      EPI8(ST_U)
#undef ST_U
    } else {
      bf16_t* dst = (bf16_t*)(p.ws + OFF_GATES) + (nt - 14) * 256;
#define ST_G(t, n, a, b, c, d) store_bf4(dst + (size_t)(t) * 2048 + (n), sigmoidf_(a), sigmoidf_(b), sigmoidf_(c), sigmoidf_(d))
      EPI8(ST_G)
#undef ST_G
    }
#undef EPI8
  }
}

template <bool RELU2>
DI void phase_gemm_plain(const bf16_t* X, int K, const bf16_t* W, int N, bf16_t* out, char* lds) {
  const int ntn = N / 256;
  __syncthreads();
  for (int it = bidx(); it < 128 * ntn; it += gridDim.x) {
    int mt = it / ntn, nt = it % ntn;
    if (ntn == 4) {
      const int r = it >> 8, w = it & 255, x = w & 7, slot = w >> 3;
      mt = 16 * x + (r & 1) * 8 + (slot >> 2); nt = slot & 3;
    }
    acc8_t acc;
#pragma unroll
    for (int a = 0; a < 2; ++a)
#pragma unroll
      for (int b = 0; b < 2; ++b)
#pragma unroll
        for (int m = 0; m < 4; ++m)
#pragma unroll
          for (int q = 0; q < 2; ++q) acc[a][b][m][q] = f32x4v{0.f, 0.f, 0.f, 0.f};
    asm volatile("s_waitcnt vmcnt(0)" ::: "memory");
    gemm_main8(acc, W + (size_t)nt * 256 * K, K, X + (size_t)mt * 256 * K, K, K / 64, lds);
    const int lane = tidx() & 63, wid = tidx() >> 6, wr = wid >> 2, wc = wid & 3, fr = lane & 15, fq = lane >> 4;
#pragma unroll
    for (int ai = 0; ai < 2; ++ai)
#pragma unroll
      for (int bj = 0; bj < 2; ++bj)
#pragma unroll
        for (int m = 0; m < 4; ++m)
#pragma unroll
          for (int q = 0; q < 2; ++q) {
            float a = acc[ai][bj][m][q][0], b = acc[ai][bj][m][q][1], c = acc[ai][bj][m][q][2], d = acc[ai][bj][m][q][3];
            if (RELU2) { a = fmaxf(a, 0.f); a *= a; b = fmaxf(b, 0.f); b *= b; c = fmaxf(c, 0.f); c *= c; d = fmaxf(d, 0.f); d *= d; }
            const int tok = mt * 256 + bj * 128 + wc * 32 + q * 16 + fr, n = nt * 256 + ai * 128 + wr * 64 + m * 16 + fq * 4;
            store_bf4(out + (size_t)tok * N + n, a, b, c, d);
          }
  }
}

constexpr int A_KB = 64 * 256, A_STAGE = 2 * A_KB, A_NST = 4;
static_assert(A_NST * A_STAGE <= LDS_BYTES && 65536 <= LDS_BYTES, "lds");
#define RAW_BARRIER() do { asm volatile("s_waitcnt lgkmcnt(0)" ::: "memory"); __builtin_amdgcn_s_barrier(); } while (0)

#define MFMA16(a, b, c) __builtin_amdgcn_mfma_f32_16x16x32_bf16((a), (b), (c), 0, 0, 0)
DI void attn_item(const Params& p, int L, int b, int h, int qblk, float lam, char* lds) {
  const int tid = tidx(), lane = tid & 63, wave = __builtin_amdgcn_readfirstlane(tid >> 6);
  const int fr = lane & 15, fq = lane >> 4, rg = wave & 3, m = wave >> 2;
  bf16_t* qg = (bf16_t*)(p.ws + OFF_Q);
  const bf16_t* kg = (const bf16_t*)(p.ws + OFF_K) + (size_t)b * L * 1024 + h * 128;
  const bf16_t* vg = (const bf16_t*)(p.ws + OFF_V) + (size_t)b * L * 1024 + h * 128;
  const size_t tok0 = (size_t)b * L + (size_t)qblk * 128;
  bf16x8 qf[2][2];
#pragma unroll
  for (int qb = 0; qb < 2; ++qb)
#pragma unroll
    for (int kd = 0; kd < 2; ++kd)
      qf[qb][kd] = *(const bf16x8*)(qg + (tok0 + rg * 32 + qb * 16 + fr) * 1024 + h * 128 + m * 64 + kd * 32 + fq * 8);
  const float kmx2 = ((const float*)(p.ws + OFF_KMAX))[(b * 8 + h) * 2 + m];
  f32x4v sv[2];
#pragma unroll
  for (int qb = 0; qb < 2; ++qb) {
    float q2 = 0.f;
#pragma unroll
    for (int kd = 0; kd < 2; ++kd)
#pragma unroll
      for (int j = 0; j < 8; ++j) { const float v = __uint_as_float((unsigned)(unsigned short)qf[qb][kd][j] << 16); q2 += v * v; }
    q2 += __shfl_xor(q2, 16); q2 += __shfl_xor(q2, 32);
    const float si = -(sqrtf(q2 * kmx2) * 1.02f + 0.125f);
    sv[qb] = f32x4v{si, si, si, si};
  }
  f32x4v oacc[8][2];
#pragma unroll
  for (int e = 0; e < 8; ++e)
#pragma unroll
    for (int q = 0; q < 2; ++q) oacc[e][q] = f32x4v{0.f, 0.f, 0.f, 0.f};
  float lsum0 = 0.f, lsum1 = 0.f;
  const int nkt = L / 64;
  const int drow = wave * 8 + (lane >> 4), dcp = lane & 15;
  const int gk0 = drow * 1024 + ((dcp ^ (drow & 15)) * 8), gk1 = (drow + 4) * 1024 + ((dcp ^ ((drow + 4) & 15)) * 8);
  const int gv0 = drow * 1024 + ((dcp ^ ((drow & 7) << 1)) * 8), gv1 = (drow + 4) * 1024 + ((dcp ^ (((drow + 4) & 7) << 1)) * 8);
  auto dma_tile = [&](int j) {
    char* st = lds + (j & 3) * A_STAGE + wave * 8 * 256;
    const bf16_t* kt = kg + (size_t)min(j + 1, nkt - 1) * 64 * 1024;
    const bf16_t* vt = vg + (size_t)j * 64 * 1024;
    __builtin_amdgcn_global_load_lds((const unsigned*)(kt + gk0), (LDS3 unsigned*)(st), 16, 0, 0);
    __builtin_amdgcn_global_load_lds((const unsigned*)(kt + gk1), (LDS3 unsigned*)(st + 4 * 256), 16, 0, 0);
    __builtin_amdgcn_global_load_lds((const unsigned*)(vt + gv0), (LDS3 unsigned*)(st + A_KB), 16, 0, 0);
    __builtin_amdgcn_global_load_lds((const unsigned*)(vt + gv1), (LDS3 unsigned*)(st + A_KB + 4 * 256), 16, 0, 0);
  };
  __syncthreads();
  __builtin_amdgcn_global_load_lds((const unsigned*)(kg + gk0), (LDS3 unsigned*)(lds + 3 * A_STAGE + wave * 8 * 256), 16, 0, 0);
  __builtin_amdgcn_global_load_lds((const unsigned*)(kg + gk1), (LDS3 unsigned*)(lds + 3 * A_STAGE + wave * 8 * 256 + 4 * 256), 16, 0, 0);
  dma_tile(0); dma_tile(1); dma_tile(2);
  LDS3 char* const l3 = (LDS3 char*)lds;
  int kro[2], vro[4];
#pragma unroll
  for (int kd = 0; kd < 2; ++kd) kro[kd] = fr * 256 + (((m * 8 + kd * 4 + fq) ^ fr) * 16);
  {
    const int tq = fr >> 2, tp = fr & 3, xs = (((fq & 1) * 4 + tq) << 1);
#pragma unroll
    for (int eb = 0; eb < 4; ++eb) vro[eb] = A_KB + (fq * 4 + tq) * 256 + ((((eb * 2 + (tp >> 1)) ^ xs)) * 16) + (tp & 1) * 8;
  }
#define SB() __builtin_amdgcn_sched_barrier(0)
#define TRR(dst, addr, imm) asm volatile("ds_read_b64_tr_b16 %0, %1 offset:%2" : "=&v"(dst) : "v"(addr), "n"(imm))
#define RVG(g, ks, ebq)                                                                                               \
  {                                                                                                                   \
    int va0 = (int)lds_addr0 + so + (vro[0] ^ ((ebq) * 128)), va1 = (int)lds_addr0 + so + (vro[1] ^ ((ebq) * 128));   \
    int va2 = (int)lds_addr0 + so + (vro[2] ^ ((ebq) * 128)), va3 = (int)lds_addr0 + so + (vro[3] ^ ((ebq) * 128));   \
    TRR(vlo[g][0], va0, (ks) * 8192); TRR(vhi[g][0], va0, (ks) * 8192 + 4096);                                        \
    TRR(vlo[g][1], va1, (ks) * 8192); TRR(vhi[g][1], va1, (ks) * 8192 + 4096);                                        \
    TRR(vlo[g][2], va2, (ks) * 8192); TRR(vhi[g][2], va2, (ks) * 8192 + 4096);                                        \
    TRR(vlo[g][3], va3, (ks) * 8192); TRR(vhi[g][3], va3, (ks) * 8192 + 4096);                                        \
  }
#define WAITV(n, g)                                                                                                   \
  asm volatile("s_waitcnt lgkmcnt(" #n ")"                                                                            \
               : "+v"(vlo[g][0]), "+v"(vhi[g][0]), "+v"(vlo[g][1]), "+v"(vhi[g][1]), "+v"(vlo[g][2]), "+v"(vhi[g][2]),  \
                 "+v"(vlo[g][3]), "+v"(vhi[g][3]));
#define MVQ(g, ks, ebq, e0)                                                                                           \
  _Pragma("unroll") for (int e = (e0); e < (e0) + 2; ++e) {                                                           \
    const bf16x8 vf = __builtin_shufflevector(vlo[g][e], vhi[g][e], 0, 1, 2, 3, 4, 5, 6, 7);                          \
    oacc[(ebq) * 4 + e][0] = MFMA16(vf, pf[ks][0], oacc[(ebq) * 4 + e][0]);                                            \
    oacc[(ebq) * 4 + e][1] = MFMA16(vf, pf[ks][1], oacc[(ebq) * 4 + e][1]);                                            \
  }
  const unsigned lds_addr0 = (unsigned)(size_t)lds;
#define RKB(dst, kb) dst[0] = *(const LDS3 bf16x8*)(l3 + kad[0] + (kb) * 4096); dst[1] = *(const LDS3 bf16x8*)(l3 + kad[1] + (kb) * 4096);
#define QK4(src, kb)                                                                                                  \
  nx[kb][0] = MFMA16(src[0], qf[0][0], sv[0]); nx[kb][1] = MFMA16(src[0], qf[1][0], sv[1]);                            \
  nx[kb][0] = MFMA16(src[1], qf[0][1], nx[kb][0]); nx[kb][1] = MFMA16(src[1], qf[1][1], nx[kb][1]);
#define EXP4T(tile, psum) _Pragma("unroll") for (int j = 0; j < 4; ++j) { tile[j] = __builtin_amdgcn_exp2f(tile[j]); psum += tile[j]; }
#define PACKP(dst, t0, t1)                                                                                            \
  {                                                                                                                   \
    uint4 u;                                                                                                          \
    u.x = pack_bf16(t0[0], t0[1]); u.y = pack_bf16(t0[2], t0[3]); u.z = pack_bf16(t1[0], t1[1]); u.w = pack_bf16(t1[2], t1[3]); \
    dst = __builtin_bit_cast(bf16x8, u);                                                                              \
  }
  typedef f32x4v stile_t[4][2];
  stile_t sA, sB;
  asm volatile("s_waitcnt vmcnt(0)" ::: "memory");
  RAW_BARRIER();
#pragma unroll
  for (int kb = 0; kb < 4; ++kb) {
    const bf16x8 k0 = *(const LDS3 bf16x8*)(l3 + 3 * A_STAGE + kro[0] + kb * 4096);
    const bf16x8 k1 = *(const LDS3 bf16x8*)(l3 + 3 * A_STAGE + kro[1] + kb * 4096);
    sA[kb][0] = MFMA16(k0, qf[0][0], sv[0]); sA[kb][1] = MFMA16(k0, qf[1][0], sv[1]);
    sA[kb][0] = MFMA16(k1, qf[0][1], sA[kb][0]); sA[kb][1] = MFMA16(k1, qf[1][1], sA[kb][1]);
  }
  auto step = [&](int t, stile_t& cx, stile_t& nx) {
    if (t + 2 < nkt) asm volatile("s_waitcnt vmcnt(8)" ::: "memory");
    else if (t + 1 < nkt) asm volatile("s_waitcnt vmcnt(4)" ::: "memory");
    else asm volatile("s_waitcnt vmcnt(0)" ::: "memory");
    RAW_BARRIER();
    const int so = (t & 3) * A_STAGE;
    int kad[2];
#pragma unroll
    for (int i = 0; i < 2; ++i) { kad[i] = so + kro[i]; asm volatile("" : "+v"(kad[i])); }
    if (t + 3 < nkt) dma_tile(t + 3);
    bf16x8 kx[2], ky[2], pf[2][2];
    s16x4 vlo[2][4], vhi[2][4];
    float ps0 = 0.f, ps1 = 0.f;
    SB();
    RKB(kx, 0) RVG(0, 0, 0)
    SB();
    RKB(ky, 1) SB(); QK4(kx, 0) EXP4T(cx[0][0], ps0) SB();
    RKB(kx, 2) SB(); QK4(ky, 1) EXP4T(cx[1][0], ps0) PACKP(pf[0][0], cx[0][0], cx[1][0]) SB();
    RKB(ky, 3) SB(); QK4(kx, 2) EXP4T(cx[0][1], ps1) SB();
    RVG(1, 0, 1) SB(); QK4(ky, 3) EXP4T(cx[1][1], ps1) PACKP(pf[0][1], cx[0][1], cx[1][1]) SB();
    WAITV(8, 0) SB(); MVQ(0, 0, 0, 0) EXP4T(cx[2][0], ps0) SB(); MVQ(0, 0, 0, 2) EXP4T(cx[3][0], ps0) PACKP(pf[1][0], cx[2][0], cx[3][0]) SB();
    RVG(0, 1, 0) SB(); WAITV(8, 1) SB(); MVQ(1, 0, 1, 0) EXP4T(cx[2][1], ps1) SB(); MVQ(1, 0, 1, 2) EXP4T(cx[3][1], ps1) PACKP(pf[1][1], cx[2][1], cx[3][1]) SB();
    RVG(1, 1, 1) SB(); WAITV(8, 0) SB(); MVQ(0, 1, 0, 0) MVQ(0, 1, 0, 2) SB();
    WAITV(0, 1) SB(); MVQ(1, 1, 1, 0) MVQ(1, 1, 1, 2) SB();
    lsum0 += ps0; lsum1 += ps1;
  };
#pragma nounroll
  for (int t = 0; t < nkt; t += 2) {
    step(t, sA, sB);
    step(t + 1, sB, sA);
  }
#undef SB
#undef TRR
#undef RVG
#undef WAITV
#undef MVQ
#undef RKB
#undef QK4
#undef EXP4T
#undef PACKP
  __syncthreads();
  float lt[2];
  lt[0] = lsum0; lt[1] = lsum1;
#pragma unroll
  for (int q = 0; q < 2; ++q) { lt[q] += __shfl_xor(lt[q], 16); lt[q] += __shfl_xor(lt[q], 32); }
  float* xb = (float*)lds;
  if (m == 1) {
#pragma unroll
    for (int q = 0; q < 2; ++q) {
      const float sc = -lam / lt[q];
#pragma unroll
      for (int e = 0; e < 8; ++e)
#pragma unroll
        for (int j = 0; j < 4; ++j) xb[(rg * 64 + (e * 2 + q) * 4 + j) * 64 + lane] = oacc[e][q][j] * sc;
    }
  }
  __syncthreads();
  if (m == 0) {
#pragma unroll
    for (int q = 0; q < 2; ++q) {
      const float sc = 1.0f / lt[q];
      float ss = 0.f;
#pragma unroll
      for (int e = 0; e < 8; ++e)
#pragma unroll
        for (int j = 0; j < 4; ++j) {
          const float o = oacc[e][q][j] * sc + xb[(rg * 64 + (e * 2 + q) * 4 + j) * 64 + lane];
          oacc[e][q][j] = o; ss += o * o;
        }
      ss += __shfl_xor(ss, 16); ss += __shfl_xor(ss, 32);
      const float rstd = rsqrtf(ss * (1.0f / 128.0f) + 1e-6f) * 0.8f;
      bf16_t* dst = qg + (tok0 + rg * 32 + q * 16 + fr) * 1024 + h * 128;
#pragma unroll
      for (int e = 0; e < 8; ++e) {
        const int ee = e * 16 + fq * 4;
        const float4 gh = *(const float4*)(p.g_head + ee);
        store_bf4(dst + ee, oacc[e][q][0] * rstd * gh.x, oacc[e][q][1] * rstd * gh.y, oacc[e][q][2] * rstd * gh.z, oacc[e][q][3] * rstd * gh.w);
      }
    }
  }
  __syncthreads();
}

DI void phase_attn(const Params& p, int hf, char* lds) {
  const int L = hf == 0 ? 16384 : 8192, B = hf == 0 ? 2 : 4;
  for (int job = bidx(); job < B * 64; job += gridDim.x) ssm_scan_job(p, hf, job, lds);
  const float lam = ((const float*)(p.ws + OFF_SCAL))[0];
  const int nqb = L / 128, rpp = nqb / 32;
  for (int it = bidx(); it < 2048; it += gridDim.x) {
    const int r = it >> 8, w = it & 255, x = w & 7, slot = w >> 3;
    const int pair = x + 8 * (r / rpp), qb = (r % rpp) * 32 + slot;
    attn_item(p, L, pair >> 3, pair & 7, qb, lam, lds);
  }
}

__global__ void __launch_bounds__(NT) fwd_megakernel(Params p) {
  __shared__ __attribute__((aligned(16))) char lds[LDS_BYTES];
  cg::grid_group grid = cg::this_grid();
  phase0a(p, lds);
  grid.sync();
  phase0b(p);
  for (int hf = 0; hf < 2; ++hf) {
    phase_h1(p, hf);
    grid.sync();
    phase_gemm_in(p, hf, lds);
    grid.sync();
    phase_ssm_states(p, lds);
    grid.sync();
    phase_attn(p, hf, lds);
    grid.sync();
    phase_ssm_out(p, lds);
    grid.sync();
    phase_glu(p, lds);
    grid.sync();
    phase_merge(p, lds);
    grid.sync();
    phase_gemm_plain<false>((const bf16_t*)(p.ws + OFF_K), 1024, (const bf16_t*)(p.ws + OFF_WOUT), 1024, (bf16_t*)(p.ws + OFF_V), lds);
    grid.sync();
    phase_x1(p, hf);
    grid.sync();
    phase_gemm_plain<true>((const bf16_t*)(p.ws + OFF_H1), 1024, (const bf16_t*)(p.ws + OFF_WFF1), 4096, (bf16_t*)(p.ws + OFF_Q), lds);
    grid.sync();
    phase_gemm_plain<false>((const bf16_t*)(p.ws + OFF_Q), 4096, (const bf16_t*)(p.ws + OFF_WFF2), 1024, (bf16_t*)(p.ws + OFF_H1), lds);
    grid.sync();
    phase_final(p, hf);
    grid.sync();
  }
}

extern "C" void kernel_launch(void* const* d_in, const int* in_sizes, int n_in, void* d_out, int out_size, void* d_ws, size_t ws_size,
                              hipStream_t stream) {
  static int grid_blocks = 0;
  if (!grid_blocks) {
    int dev = 0, cus = 0, per_cu = 0;
    hipGetDevice(&dev);
    hipDeviceGetAttribute(&cus, hipDeviceAttributeMultiprocessorCount, dev);
    hipOccupancyMaxActiveBlocksPerMultiprocessor(&per_cu, fwd_megakernel, NT, 0);
    if (per_cu < 1) per_cu = 1;
    grid_blocks = cus * 1;
  }
  Params p{};
  const float* const* in = (const float* const*)d_in;
  p.x[0] = in[0]; p.x[1] = in[1]; p.c[0] = in[2]; p.c[1] = in[3];
  p.w_ada = in[4]; p.b_ada = in[5]; p.g_pre_mix = in[6]; p.g_post_mix = in[7]; p.g_pre_ffn = in[8]; p.g_post_ffn = in[9];
  p.w_in = in[10]; p.lam_q1 = in[11]; p.lam_k1 = in[12]; p.lam_q2 = in[13]; p.lam_k2 = in[14]; p.g_head = in[15];
  p.lam_re[0] = in[16]; p.lam_im[0] = in[17]; p.log_step[0] = in[18]; p.c_re[0] = in[19]; p.c_im[0] = in[20];
  p.lam_re[1] = in[21]; p.lam_im[1] = in[22]; p.log_step[1] = in[23]; p.c_re[1] = in[24]; p.c_im[1] = in[25];
  p.b_re = in[26]; p.b_im = in[27]; p.ssm_d = in[28]; p.w_glu = in[29]; p.b_glu = in[30]; p.w_pa = in[31]; p.w_ps = in[32];
  p.w_out = in[33]; p.w_ff1 = in[34]; p.w_ff2 = in[35];
  p.out = (float*)d_out;
  p.ws = (char*)d_ws;
  void* args[] = {&p};
  hipError_t e = hipLaunchCooperativeKernel((void*)fwd_megakernel, dim3(grid_blocks), dim3(NT), args, 0, stream);
  if (e != hipSuccess) fprintf(stderr, "cooperative launch failed: %s (grid %d)\n", hipGetErrorString(e), grid_blocks);
}
```

```cpp
#include <hip/hip_runtime.h>
#include <hip/hip_cooperative_groups.h>
#include <cstdint>
#include <cstdio>
namespace cg = cooperative_groups;

#define DI __device__ __forceinline__
typedef unsigned short bf16_t;
typedef short bf16x8 __attribute__((ext_vector_type(8)));
typedef short s16x4 __attribute__((ext_vector_type(4)));
typedef float f32x16 __attribute__((ext_vector_type(16)));
typedef __bf16 bf2_t __attribute__((ext_vector_type(2)));
typedef float f2_t __attribute__((ext_vector_type(2)));
#define MFMA32(a, b, c) __builtin_amdgcn_mfma_f32_32x32x16_bf16((a), (b), (c), 0, 0, 0)
#define LDS3 __attribute__((address_space(3)))

constexpr int NT = 512;
constexpr int D = 1024, DFF = 4096, INW = 5632;
constexpr int HALF_TOK = 32768;
constexpr int TCH = 32;
constexpr int NCH = HALF_TOK / TCH;

constexpr size_t SZ_WIN = (size_t)INW * D * 2, SZ_WPA = (size_t)D * D * 2, SZ_WPS = (size_t)D * 512 * 2, SZ_WGLU = 512 * 512 * 2,
                 SZ_WOUT = (size_t)D * D * 2, SZ_WFF = (size_t)D * DFF * 2, SZ_WEND = (size_t)32 * 256 * 512 * 2,
                 SZ_WTOEP = (size_t)32 * 512 * 768 * 2, SZ_KTAB = (size_t)32 * 2 * 32 * 256 * 4, SZ_MOD = 6 * 6144 * 4,
                 SZ_ROPE = (size_t)16384 * 8 * 2 * 4;
constexpr size_t OFF_WIN = 0, OFF_WPA = OFF_WIN + SZ_WIN, OFF_WPS = OFF_WPA + SZ_WPA, OFF_WGLU = OFF_WPS + SZ_WPS,
                 OFF_WOUT = OFF_WGLU + SZ_WGLU, OFF_WFF1 = OFF_WOUT + SZ_WOUT, OFF_WFF2 = OFF_WFF1 + SZ_WFF,
                 OFF_WEND = OFF_WFF2 + SZ_WFF, OFF_WTOEP = OFF_WEND + SZ_WEND, OFF_KTAB = OFF_WTOEP + SZ_WTOEP,
                 OFF_MOD = OFF_KTAB + SZ_KTAB, OFF_ROPE = OFF_MOD + SZ_MOD, OFF_SCAL = OFF_ROPE + SZ_ROPE,
                 OFF_KMAX = OFF_SCAL + 256, OFF_H1 = OFF_SCAL + 1024;
constexpr size_t SZ_TOK1K = (size_t)HALF_TOK * 1024 * 2;
constexpr size_t OFF_Q = OFF_H1 + SZ_TOK1K, OFF_K = OFF_Q + SZ_TOK1K, OFF_V = OFF_K + SZ_TOK1K, OFF_U = OFF_V + SZ_TOK1K,
                 OFF_GATES = OFF_U + SZ_TOK1K / 2, WS_END = OFF_GATES + 2 * SZ_TOK1K;
constexpr size_t OFF_S = OFF_H1, OFF_XIN = OFF_H1 + (size_t)NCH * 32 * 256 * 4;
static_assert(OFF_XIN + (size_t)NCH * 32 * 256 * 2 <= OFF_Q, "h1 region overflow");
static_assert(WS_END <= (size_t)512 * 1024 * 1024, "workspace too large");
static_assert((size_t)HALF_TOK * DFF * 2 <= WS_END - OFF_Q, "act does not fit");
static_assert(OFF_H1 % 256 == 0, "align");
constexpr size_t OFF_Q8 = (size_t)32 * 1024 * 1024;

struct Params {
  const float* x[2];
  const float* c[2];
  const float *w_ada, *b_ada, *g_pre_mix, *g_post_mix, *g_pre_ffn, *g_post_ffn, *w_in, *lam_q1, *lam_k1, *lam_q2, *lam_k2, *g_head;
  const float *lam_re[2], *lam_im[2], *log_step[2], *c_re[2], *c_im[2];
  const float *b_re, *b_im, *ssm_d, *w_glu, *b_glu, *w_pa, *w_ps, *w_out, *w_ff1, *w_ff2;
  float* out;
  char* ws;
};

DI int tidx() { int t = threadIdx.x; asm volatile("" : "+v"(t)); return t; }
DI int bidx() { int b = blockIdx.x; asm volatile("" : "+s"(b)); return b; }
DI unsigned pack_bf16(float a, float b) { f2_t v = {a, b}; bf2_t r = __builtin_convertvector(v, bf2_t); return __builtin_bit_cast(unsigned, r); }
DI float bf_lo(unsigned u) { return __uint_as_float(u << 16); }
DI float bf_hi(unsigned u) { return __uint_as_float(u & 0xffff0000u); }
DI float fast_exp(float x) { return __builtin_amdgcn_exp2f(x * 1.44269504089f); }
DI float sigmoidf_(float z) { return 1.0f / (1.0f + fast_exp(-z)); }
DI float gelu_tanh(float y) {
  const float z = 0.7978845608028654f * (y + 0.044715f * y * y * y);
  const float e = fast_exp(2.0f * z);
  const float th = 1.0f - 2.0f / (e + 1.0f);
  return 0.5f * y * (1.0f + th);
}
DI float xhalf_max(float v) {
  const auto r = __builtin_amdgcn_permlane32_swap(__float_as_uint(v), __float_as_uint(v), false, false);
  return fmaxf(__uint_as_float(r[0]), __uint_as_float(r[1]));
}
DI float xhalf_sum(float v) {
  const auto r = __builtin_amdgcn_permlane32_swap(__float_as_uint(v), __float_as_uint(v), false, false);
  return __uint_as_float(r[0]) + __uint_as_float(r[1]);
}
DI float wave_sum(float v) {
#pragma unroll
  for (int o = 32; o >= 1; o >>= 1) v += __shfl_xor(v, o);
  return v;
}

constexpr int RS_G = 144;
constexpr int G_STAGE = (256 + 256) * RS_G;
constexpr int LDS_BYTES = 151552;
static_assert(2 * G_STAGE <= LDS_BYTES, "lds");
typedef f32x16 acc_t[2][4];

#define G_RAW_BARRIER() do { asm volatile("s_waitcnt lgkmcnt(0)" ::: "memory"); __builtin_amdgcn_s_barrier(); } while (0)
constexpr int GD_STAGE = 65536;
static_assert(2 * GD_STAGE <= LDS_BYTES, "lds");
template <class XF>
DI void gemm_main(acc_t& acc, const XF& xf, const bf16_t* __restrict__ W, int ldw, int nk, char* lds) {
  const int tid = tidx(), lane = tid & 63, wave = __builtin_amdgcn_readfirstlane(tid >> 6);
  const int lq = lane & 31, hi = lane >> 5, wt = wave & 1, wn = wave >> 1;
  const int drow = wave * 8 + (lane >> 3), dcp = lane & 7;
  auto dma_step = [&](int kt, int stage) {
    char* st = lds + stage * GD_STAGE + wave * 1024;
#pragma unroll
    for (int i = 0; i < 4; ++i) {
      const int row = i * 64 + drow;
      const int c = dcp ^ ((row >> 1) & 7);
      __builtin_amdgcn_global_load_lds((const unsigned*)xf(row, kt * 8 + c), (LDS3 unsigned*)(st + i * 8192), 16, 0, 0);
    }
#pragma unroll
    for (int i = 0; i < 4; ++i) {
      const int row = i * 64 + drow;
      const int c = dcp ^ ((row >> 1) & 7);
      __builtin_amdgcn_global_load_lds((const unsigned*)(W + (size_t)row * ldw + (kt * 8 + c) * 8), (LDS3 unsigned*)(st + 32768 + i * 8192), 16, 0, 0);
    }
  };
  __syncthreads();
  dma_step(0, 0);
  asm volatile("s_waitcnt vmcnt(0)" ::: "memory");
  G_RAW_BARRIER();
  const int swz = (lq >> 1) & 7;
  const int xrow = (wt * 128 + lq) * 128, wrow = 32768 + (wn * 64 + lq) * 128;
  for (int kt = 0; kt < nk; ++kt) {
    if (kt + 1 < nk) dma_step(kt + 1, (kt + 1) & 1);
    const int sb = (kt & 1) * GD_STAGE;
#define GSB() __builtin_amdgcn_sched_barrier(0)
#define LOADF(f, ks)                                                                                   \
  {                                                                                                    \
    int co = (((ks) * 2 + hi) ^ swz) * 16;                                                             \
    int xo = sb + xrow + co, wo = sb + wrow + co;                                                      \
    asm volatile("" : "+v"(xo)); asm volatile("" : "+v"(wo));                                          \
    const LDS3 char* Xs = (LDS3 char*)lds + xo; const LDS3 char* Ws = (LDS3 char*)lds + wo;            \
    f[0] = *(const LDS3 bf16x8*)(Ws); f[1] = *(const LDS3 bf16x8*)(Ws + 4096);                         \
    f[2] = *(const LDS3 bf16x8*)(Xs); f[3] = *(const LDS3 bf16x8*)(Xs + 4096);                         \
    f[4] = *(const LDS3 bf16x8*)(Xs + 8192); f[5] = *(const LDS3 bf16x8*)(Xs + 12288);                 \
  }
#define MM(f)                                                                                          \
  acc[0][0] = MFMA32(f[0], f[2], acc[0][0]); acc[1][0] = MFMA32(f[1], f[2], acc[1][0]);                \
  acc[0][1] = MFMA32(f[0], f[3], acc[0][1]); acc[1][1] = MFMA32(f[1], f[3], acc[1][1]);                \
  acc[0][2] = MFMA32(f[0], f[4], acc[0][2]); acc[1][2] = MFMA32(f[1], f[4], acc[1][2]);                \
  acc[0][3] = MFMA32(f[0], f[5], acc[0][3]); acc[1][3] = MFMA32(f[1], f[5], acc[1][3]);
    {
      bf16x8 fa[6], fb[6];
      GSB();
      LOADF(fa, 0) GSB();
      LOADF(fb, 1) GSB(); MM(fa) GSB();
      LOADF(fa, 2) GSB(); MM(fb) GSB();
      LOADF(fb, 3) GSB(); MM(fa) GSB();
      MM(fb) GSB();
    }
#undef GSB
#undef LOADF
#undef MM
    asm volatile("s_waitcnt vmcnt(0)" ::: "memory");
    G_RAW_BARRIER();
  }
}

DI void zero_acc(acc_t& acc) {
#pragma unroll
  for (int a = 0; a < 2; ++a)
#pragma unroll
    for (int b = 0; b < 4; ++b)
#pragma unroll
      for (int i = 0; i < 16; ++i) acc[a][b][i] = 0.f;
}

struct XPlain {
  const bf16_t* base; int ld;
  DI const uint4* operator()(int row, int kc) const { return (const uint4*)(base + (size_t)row * ld + kc * 8); }
};
struct XSsm {
  const bf16_t* ubase;
  const bf16_t* xin;
  DI const uint4* operator()(int row, int kc) const {
    if (kc < 64) return (const uint4*)(ubase + (size_t)(row * 32 + (kc >> 1)) * 512 + (kc & 1) * 8);
    return (const uint4*)(xin + (size_t)row * (32 * 256) + (kc - 64) * 8);
  }
};

template <class F>
DI void epi_iter(const acc_t& acc, F f) {
  const int lane = tidx() & 63, wave = tidx() >> 6;
  const int lq = lane & 31, hi = lane >> 5, wt = wave & 1, wn = wave >> 1;
#pragma unroll
  for (int nb = 0; nb < 2; ++nb)
#pragma unroll
    for (int tb = 0; tb < 4; ++tb)
#pragma unroll
      for (int gi = 0; gi < 4; ++gi)
        f(wt * 128 + tb * 32 + lq, wn * 64 + nb * 32 + gi * 8 + hi * 4, acc[nb][tb][gi * 4 + 0], acc[nb][tb][gi * 4 + 1],
          acc[nb][tb][gi * 4 + 2], acc[nb][tb][gi * 4 + 3]);
}
DI void store_bf4(bf16_t* p, float a, float b, float c, float d) {
  uint2 v; v.x = pack_bf16(a, b); v.y = pack_bf16(c, d);
  *(uint2*)p = v;
}

DI void transpose_tile(const float* __restrict__ W, bf16_t* __restrict__ Wt, int K, int N, int kt, int nt, char* lds) {
  float (*t)[65] = (float (*)[65])lds;
  const int tid = tidx();
  const int c = tid & 63, r0 = tid >> 6;
  __syncthreads();
#pragma unroll
  for (int i = 0; i < 8; ++i) { const int k = r0 + 8 * i; t[k][c] = W[(size_t)(kt * 64 + k) * N + nt * 64 + c]; }
  __syncthreads();
  const int kk = (tid & 31) * 2, nn = tid >> 5;
#pragma unroll
  for (int i = 0; i < 4; ++i) {
    const int n = nn + 16 * i;
    *(unsigned*)(Wt + (size_t)(nt * 64 + n) * K + kt * 64 + kk) = pack_bf16(t[kk][n], t[kk + 1][n]);
  }
}

DI void sincos_rev(double ang, float& s, float& c) {
  double r = ang * 0.15915494309189533577;
  r -= rint(r);
  const float fr = (float)r;
  s = __builtin_amdgcn_sinf(fr);
  c = __builtin_amdgcn_cosf(fr);
}

DI void ssm_tables(const Params& p, int g, int dir, char* lds) {
  float2 (*Apow)[64] = (float2 (*)[64])lds;
  float2 (*Bb)[16] = (float2 (*)[16])(lds + 33 * 64 * 8);
  float2 (*Cc)[64] = (float2 (*)[64])(lds + 33 * 64 * 8 + 64 * 16 * 8);
  float2* cz = (float2*)(lds + 33 * 64 * 8 + 2 * 64 * 16 * 8);
  const int tid = tidx();
  __syncthreads();
  const double step = exp((double)p.log_step[dir][g]);
  if (tid < 64) {
    const int n = tid;
    const double lre = (double)p.lam_re[dir][g * 64 + n], lim = (double)p.lam_im[dir][g * 64 + n];
#pragma nounroll
    for (int tau = 0; tau <= 32; ++tau) {
      float s, c; sincos_rev(lim * step * tau, s, c);
      const float mag = (float)exp(lre * step * tau);
      Apow[tau][n] = make_float2(mag * c, mag * s);
    }
    double sd, cd; sincos(lim * step, &sd, &cd);
    const double ea = exp(lre * step);
    const double ar = ea * cd, ai = ea * sd, nr = ar - 1.0, den = lre * lre + lim * lim;
    cz[n] = make_float2((float)((nr * lre + ai * lim) / den), (float)((ai * lre - nr * lim) / den));
  }
  __syncthreads();
  for (int e = tid; e < 1024; e += NT) {
    const int n = e >> 4, q = e & 15;
    const float br = p.b_re[(g * 64 + n) * 16 + q], bi = p.b_im[(g * 64 + n) * 16 + q];
    const float2 z = cz[n];
    Bb[n][q] = make_float2(z.x * br - z.y * bi, z.x * bi + z.y * br);
    const int pp = e >> 6, nn = e & 63;
    Cc[pp][nn] = make_float2(p.c_re[dir][(g * 16 + pp) * 64 + nn], p.c_im[dir][(g * 16 + pp) * 64 + nn]);
  }
  __syncthreads();
  float* ktab = (float*)(p.ws + OFF_KTAB) + (size_t)(g * 2 + dir) * 32 * 256;
  for (int e = tid; e < 32 * 256; e += NT) {
    const int tau = e >> 8, pp = (e >> 4) & 15, q = e & 15;
    float acc = 0.f;
#pragma unroll 4
    for (int n = 0; n < 64; ++n) {
      const float2 a = Apow[tau][n], cc = Cc[pp][n], b = Bb[n][q];
      const float gr = cc.x * a.x - cc.y * a.y, gi = cc.x * a.y + cc.y * a.x;
      acc += gr * b.x - gi * b.y;
    }
    ktab[e] = acc;
  }
  bf16_t* wend = (bf16_t*)(p.ws + OFF_WEND) + (size_t)g * 256 * 512 + (size_t)dir * 128 * 512;
  for (int e = tid; e < 128 * 256; e += NT) {
    const int row = e >> 8, k = (e & 255) * 2;
    const int n = row >> 1, ri = row & 1, t = k >> 4, pp = k & 15;
    const float2 a = Apow[dir == 0 ? 31 - t : t][n];
    const float2 b0 = Bb[n][pp], b1 = Bb[n][pp + 1];
    const float v0 = ri == 0 ? (a.x * b0.x - a.y * b0.y) : (a.x * b0.y + a.y * b0.x);
    const float v1 = ri == 0 ? (a.x * b1.x - a.y * b1.y) : (a.x * b1.y + a.y * b1.x);
    *(unsigned*)(wend + (size_t)row * 512 + k) = pack_bf16(v0, v1);
  }
  bf16_t* wt = (bf16_t*)(p.ws + OFF_WTOEP) + (size_t)g * 512 * 768 + 512 + dir * 128;
  for (int e = tid; e < 512 * 64; e += NT) {
    const int row = e >> 6, n = e & 63, t = row >> 4, pp = row & 15;
    const float2 a = Apow[dir == 0 ? t + 1 : 32 - t][n], cc = Cc[pp][n];
    const float gr = cc.x * a.x - cc.y * a.y, gi = cc.x * a.y + cc.y * a.x;
    *(unsigned*)(wt + (size_t)row * 768 + n * 2) = pack_bf16(gr, -gi);
  }
}

DI void mod_item(const Params& p, int j, char* lds) {
  float (*sc)[1024] = (float (*)[1024])lds;
  float* red = (float*)(lds + 6 * 1024 * 4);
  const int tid = tidx();
  __syncthreads();
  for (int e = tid; e < 6144; e += NT) {
    const int b = e >> 10, k = e & 1023;
    const float v = b < 2 ? p.c[0][b * 1024 + k] : p.c[1][(b - 2) * 1024 + k];
    sc[b][k] = v * sigmoidf_(v);
  }
  __syncthreads();
  const int col = tid & 31, kq = tid >> 5;
  if (col < 24) {
    float a[6] = {0.f, 0.f, 0.f, 0.f, 0.f, 0.f};
#pragma unroll 4
    for (int k = kq; k < 1024; k += 16) {
      const float w = p.w_ada[(size_t)k * 6144 + j * 24 + col];
#pragma unroll
      for (int b = 0; b < 6; ++b) a[b] += sc[b][k] * w;
    }
#pragma unroll
    for (int b = 0; b < 6; ++b) red[(kq * 6 + b) * 24 + col] = a[b];
  }
  __syncthreads();
  if (tid < 144) {
    const int b = tid / 24, c2 = tid % 24;
    float s = p.b_ada[j * 24 + c2];
    for (int q = 0; q < 16; ++q) s += red[(q * 6 + b) * 24 + c2];
    ((float*)(p.ws + OFF_MOD))[b * 6144 + j * 24 + c2] = s;
  }
}

DI void phase0a(const Params& p, char* lds) {
  const int tid = tidx();
  constexpr int N_SSM = 64, N_MOD = 256, N_ROPE = 32, N_LAM = 1;
  constexpr int T_WIN = 16 * 88, T_WPA = 16 * 16, T_WPS = 8 * 16, T_WGLU = 8 * 8, T_WOUT = 16 * 16, T_FF1 = 16 * 64, T_FF2 = 64 * 16;
  constexpr int B0 = N_SSM + N_MOD + N_ROPE + N_LAM;
  constexpr int NITEMS = B0 + T_WIN + T_WPA + T_WPS + T_WGLU + T_WOUT + T_FF1 + T_FF2;
  for (int it = bidx(); it < NITEMS; it += gridDim.x) {
    if (it < N_SSM) { ssm_tables(p, it >> 1, it & 1, lds); continue; }
    int i = it - N_SSM;
    if (i < N_MOD) { mod_item(p, i, lds); continue; }
    i -= N_MOD;
    if (i < N_ROPE) {
      float2* rope = (float2*)(p.ws + OFF_ROPE);
      for (int e = tid; e < 4096; e += NT) {
        const int pos = i * 512 + (e >> 3), f = e & 7;
        const double invf = exp2(-(double)f * 0.125 * 18.931568569324174);
        float s, c; sincos_rev((double)pos * invf, s, c);
        rope[pos * 8 + f] = make_float2(c, s);
      }
      continue;
    }
    i -= N_ROPE;
    if (i < N_LAM) {
      if (tid == 0) {
        float s1 = 0.f, s2 = 0.f;
        for (int k = 0; k < 64; ++k) { s1 += p.lam_q1[k] * p.lam_k1[k]; s2 += p.lam_q2[k] * p.lam_k2[k]; }
        ((float*)(p.ws + OFF_SCAL))[0] = expf(s1) - expf(s2) + 0.2f;
      }
      continue;
    }
    i -= N_LAM;
    if (i < T_WIN) { transpose_tile(p.w_in, (bf16_t*)(p.ws + OFF_WIN), 1024, INW, i / 88, i % 88, lds); continue; }
    i -= T_WIN;
    if (i < T_WPA) { transpose_tile(p.w_pa, (bf16_t*)(p.ws + OFF_WPA), 1024, 1024, i / 16, i % 16, lds); continue; }
    i -= T_WPA;
    if (i < T_WPS) { transpose_tile(p.w_ps, (bf16_t*)(p.ws + OFF_WPS), 512, 1024, i / 16, i % 16, lds); continue; }
    i -= T_WPS;
    if (i < T_WGLU) { transpose_tile(p.w_glu, (bf16_t*)(p.ws + OFF_WGLU), 512, 512, i / 8, i % 8, lds); continue; }
    i -= T_WGLU;
    if (i < T_WOUT) { transpose_tile(p.w_out, (bf16_t*)(p.ws + OFF_WOUT), 1024, 1024, i / 16, i % 16, lds); continue; }
    i -= T_WOUT;
    if (i < T_FF1) { transpose_tile(p.w_ff1, (bf16_t*)(p.ws + OFF_WFF1), 1024, 4096, i / 64, i % 64, lds); continue; }
    i -= T_FF1;
    transpose_tile(p.w_ff2, (bf16_t*)(p.ws + OFF_WFF2), 4096, 1024, i / 16, i % 16, lds);
  }
}

DI void phase0b(const Params& p) {
  const int tid = tidx();
  const float* ktab = (const float*)(p.ws + OFF_KTAB);
  for (int it = bidx(); it < 32 * 16; it += gridDim.x) {
    const int g = it >> 4, rb = it & 15;
    bf16_t* wt = (bf16_t*)(p.ws + OFF_WTOEP) + (size_t)g * 512 * 768;
    const float* kf = ktab + (size_t)(g * 2 + 0) * 32 * 256;
    const float* kb = ktab + (size_t)(g * 2 + 1) * 32 * 256;
    for (int e = tid; e < 32 * 256; e += NT) {
      const int row = rb * 32 + (e >> 8), k = (e & 255) * 2;
      const int t = row >> 4, pp = row & 15, s = k >> 4, q = k & 15;
      float v0 = 0.f, v1 = 0.f;
      if (t >= s) { v0 += kf[(t - s) * 256 + pp * 16 + q]; v1 += kf[(t - s) * 256 + pp * 16 + q + 1]; }
      if (s >= t) { v0 += kb[(s - t) * 256 + pp * 16 + q]; v1 += kb[(s - t) * 256 + pp * 16 + q + 1]; }
      *(unsigned*)(wt + (size_t)row * 768 + k) = pack_bf16(v0, v1);
    }
  }
}

DI void load_row16(const float* r, int lane, float (&v)[16]) {
#pragma unroll
  for (int j = 0; j < 4; ++j) { const float4 t = *(const float4*)(r + j * 256 + lane * 4); v[j * 4] = t.x; v[j * 4 + 1] = t.y; v[j * 4 + 2] = t.z; v[j * 4 + 3] = t.w; }
}
DI void load_row16_bf(const bf16_t* r, int lane, float (&v)[16]) {
#pragma unroll
  for (int j = 0; j < 4; ++j) { const uint2 t = *(const uint2*)(r + j * 256 + lane * 4); v[j * 4] = bf_lo(t.x); v[j * 4 + 1] = bf_hi(t.x); v[j * 4 + 2] = bf_lo(t.y); v[j * 4 + 3] = bf_hi(t.y); }
}

DI void modnorm_store(const float (&x)[16], int lane, const float* g, const float* sc, const float* sh, bf16_t* dst) {
  float ss = 0.f;
#pragma unroll
  for (int i = 0; i < 16; ++i) ss += x[i] * x[i];
  ss = wave_sum(ss);
  const float rstd = rsqrtf(ss * (1.0f / 1024.0f) + 1e-6f);
#pragma unroll
  for (int j = 0; j < 4; ++j) {
    const int c = j * 256 + lane * 4;
    const float4 gg = *(const float4*)(g + c), s1 = *(const float4*)(sc + c), s0 = *(const float4*)(sh + c);
    store_bf4(dst + c, x[j * 4] * rstd * gg.x * (1.f + s1.x) + s0.x, x[j * 4 + 1] * rstd * gg.y * (1.f + s1.y) + s0.y,
              x[j * 4 + 2] * rstd * gg.z * (1.f + s1.z) + s0.z, x[j * 4 + 3] * rstd * gg.w * (1.f + s1.w) + s0.w);
  }
}

DI void phase_h1(const Params& p, int hf) {
  if (bidx() == 0 && tidx() < 64) ((float*)(p.ws + OFF_KMAX))[tidx()] = 0.f;
  const int lane = tidx() & 63, gw = bidx() * 8 + (tidx() >> 6), nw = gridDim.x * 8;
  const int lsh = hf == 0 ? 14 : 13;
  const float* mod = (const float*)(p.ws + OFF_MOD);
  bf16_t* h1 = (bf16_t*)(p.ws + OFF_H1);
  for (int row = gw; row < HALF_TOK; row += nw) {
    const int b = (hf == 0 ? 0 : 2) + (row >> lsh);
    float x[16]; load_row16(p.x[hf] + (size_t)row * 1024, lane, x);
    modnorm_store(x, lane, p.g_pre_mix, mod + b * 6144 + 1024, mod + b * 6144, h1 + (size_t)row * 1024);
  }
}

DI void phase_x1(const Params& p, int hf) {
  const int lane = tidx() & 63, gw = bidx() * 8 + (tidx() >> 6), nw = gridDim.x * 8;
  const int lsh = hf == 0 ? 14 : 13;
  const float* mod = (const float*)(p.ws + OFF_MOD);
  const bf16_t* mix = (const bf16_t*)(p.ws + OFF_V);
  bf16_t* h2 = (bf16_t*)(p.ws + OFF_H1);
  float* outp = p.out + (size_t)hf * HALF_TOK * 1024;
  for (int row = gw; row < HALF_TOK; row += nw) {
    const int b = (hf == 0 ? 0 : 2) + (row >> lsh);
    const float* mb = mod + b * 6144;
    float x[16], m[16];
    load_row16(p.x[hf] + (size_t)row * 1024, lane, x);
    load_row16_bf(mix + (size_t)row * 1024, lane, m);
    float ss = 0.f;
#pragma unroll
    for (int i = 0; i < 16; ++i) ss += m[i] * m[i];
    ss = wave_sum(ss);
    const float rstd = rsqrtf(ss * (1.0f / 1024.0f) + 1e-6f);
#pragma unroll
    for (int j = 0; j < 4; ++j) {
      const int c = j * 256 + lane * 4;
      const float4 gg = *(const float4*)(p.g_post_mix + c), gt = *(const float4*)(mb + 2048 + c);
      x[j * 4] += gt.x * m[j * 4] * rstd * gg.x; x[j * 4 + 1] += gt.y * m[j * 4 + 1] * rstd * gg.y;
      x[j * 4 + 2] += gt.z * m[j * 4 + 2] * rstd * gg.z; x[j * 4 + 3] += gt.w * m[j * 4 + 3] * rstd * gg.w;
      *(float4*)(outp + (size_t)row * 1024 + c) = make_float4(x[j * 4], x[j * 4 + 1], x[j * 4 + 2], x[j * 4 + 3]);
    }
    modnorm_store(x, lane, p.g_pre_ffn, mb + 4096, mb + 3072, h2 + (size_t)row * 1024);
  }
}

DI void phase_final(const Params& p, int hf) {
  const int lane = tidx() & 63, gw = bidx() * 8 + (tidx() >> 6), nw = gridDim.x * 8;
  const int lsh = hf == 0 ? 14 : 13;
  const float* mod = (const float*)(p.ws + OFF_MOD);
  const bf16_t* fb = (const bf16_t*)(p.ws + OFF_H1);
  float* outp = p.out + (size_t)hf * HALF_TOK * 1024;
  for (int row = gw; row < HALF_TOK; row += nw) {
    const int b = (hf == 0 ? 0 : 2) + (row >> lsh);
    const float* mb = mod + b * 6144;
    float x[16], m[16];
    load_row16(outp + (size_t)row * 1024, lane, x);
    load_row16_bf(fb + (size_t)row * 1024, lane, m);
    float ss = 0.f;
#pragma unroll
    for (int i = 0; i < 16; ++i) ss += m[i] * m[i];
    ss = wave_sum(ss);
    const float rstd = rsqrtf(ss * (1.0f / 1024.0f) + 1e-6f);
#pragma unroll
    for (int j = 0; j < 4; ++j) {
      const int c = j * 256 + lane * 4;
      const float4 gg = *(const float4*)(p.g_post_ffn + c), gt = *(const float4*)(mb + 5120 + c);
      *(float4*)(outp + (size_t)row * 1024 + c) =
          make_float4(x[j * 4] + gt.x * m[j * 4] * rstd * gg.x, x[j * 4 + 1] + gt.y * m[j * 4 + 1] * rstd * gg.y,
                      x[j * 4 + 2] + gt.z * m[j * 4 + 2] * rstd * gg.z, x[j * 4 + 3] + gt.w * m[j * 4 + 3] * rstd * gg.w);
    }
  }
}

DI void ssm_scan_job(const Params& p, int hf, int job, char* lds) {
  const int lane = tidx() & 63, wave = __builtin_amdgcn_readfirstlane(tidx() >> 6);
  const int nc = hf == 0 ? 512 : 256;
  const int len = nc >> 3;
  const int b = job >> 6, g = (job >> 1) & 31, dir = job & 1, n = lane;
  const double step = exp((double)p.log_step[dir][g]);
  const double lre = (double)p.lam_re[dir][g * 64 + n], lim = (double)p.lam_im[dir][g * 64 + n];
  float s, c; sincos_rev(lim * step * (double)TCH, s, c);
  const float mag = (float)exp(lre * step * (double)TCH);
  const float ar = mag * c, ai = mag * s;
  float s2, c2; sincos_rev(lim * step * (double)(TCH * len), s2, c2);
  const float mag2 = (float)exp(lre * step * (double)(TCH * len));
  const float pr = mag2 * c2, pi = mag2 * s2;
  const float* S = (const float*)(p.ws + OFF_S) + ((size_t)(b * nc) * 32 + g) * 256 + dir * 128 + n * 2;
  unsigned* X = (unsigned*)((bf16_t*)(p.ws + OFF_XIN) + ((size_t)(b * nc) * 32 + g) * 256 + dir * 128 + n * 2);
  const int c0 = dir == 0 ? 0 : nc - 1;
  const long cs = dir == 0 ? 1 : -1;
  const int i0 = wave * len;
  float2* E = (float2*)lds;
  __syncthreads();
  float xr = 0.f, xi = 0.f;
  for (int cb = i0; cb < i0 + len; cb += 16) {
    float2 sv[16];
#pragma unroll
    for (int j = 0; j < 16; ++j) sv[j] = *(const float2*)(S + (size_t)(c0 + cs * (cb + j)) * (32 * 256));
#pragma unroll
    for (int j = 0; j < 16; ++j) {
      const float nr = ar * xr - ai * xi + sv[j].x, ni = ar * xi + ai * xr + sv[j].y;
      xr = nr; xi = ni;
    }
  }
  E[wave * 64 + lane] = make_float2(xr, xi);
  __syncthreads();
  xr = 0.f; xi = 0.f;
  for (int v = 0; v < wave; ++v) {
    const float2 e = E[v * 64 + lane];
    const float nr = pr * xr - pi * xi + e.x, ni = pr * xi + pi * xr + e.y;
    xr = nr; xi = ni;
  }
  for (int cb = i0; cb < i0 + len; cb += 16) {
    float2 sv[16];
#pragma unroll
    for (int j = 0; j < 16; ++j) sv[j] = *(const float2*)(S + (size_t)(c0 + cs * (cb + j)) * (32 * 256));
#pragma unroll
    for (int j = 0; j < 16; ++j) {
      X[(size_t)(c0 + cs * (cb + j)) * (32 * 256 / 2)] = pack_bf16(xr, xi);
      const float nr = ar * xr - ai * xi + sv[j].x, ni = ar * xi + ai * xr + sv[j].y;
      xr = nr; xi = ni;
    }
  }
}

typedef float f32x4v __attribute__((ext_vector_type(4)));
typedef f32x4v acc8_t[2][2][4][2];
constexpr int P8_HB = 128 * 64 * 2;
static_assert(8 * P8_HB <= LDS_BYTES, "lds");
DI int p8_lds_byte(int r, int c) { const int st = (r >> 4) * 2 + (c >> 5), rr = r & 15, cc = c & 31, ob = rr * 64 + cc * 2; return st * 1024 + (ob ^ (((ob >> 9) & 1) << 5)); }
DI void p8_stage_rc(int b, int& R, int& C) { const int st = b / 1024, sb = b % 1024, swz = sb ^ (((sb >> 9) & 1) << 5); R = (st >> 1) * 16 + swz / 64; C = (st & 1) * 32 + (swz % 64) / 2; }

template <int XMODE = 0>
DI void gemm_main8(acc8_t& acc, const bf16_t* __restrict__ Wt, int ldw, const bf16_t* __restrict__ Xt, int ldx, int nt, char* lds,
                   const bf16_t* __restrict__ X2 = nullptr) {
  const int tid = tidx(), wid = __builtin_amdgcn_readfirstlane(tid >> 6), lane = tid & 63;
  const int wr = wid >> 2, wc = wid & 3, fr = lane & 15, fq = lane >> 4;
#define P8SA(b, h) (lds + ((b) * 2 + (h)) * P8_HB)
#define P8SB(b, h) (lds + (4 + (b) * 2 + (h)) * P8_HB)
  int p8r0, p8c0; p8_stage_rc(tid * 16, p8r0, p8c0);
  const unsigned offA = (unsigned)(p8r0 * ldw + p8c0) * 2u;
  const unsigned offB = XMODE == 0 ? (unsigned)(p8r0 * ldx + p8c0) * 2u
                                   : (unsigned)(p8r0 * 16384 + (p8c0 >> 4) * 512 + ((p8c0 >> 3) & 1) * 8) * 2u;
  const unsigned offB2 = (unsigned)(p8r0 * 8192 + p8c0) * 2u;
#define P8STAGE_A(P, half, kt)                                                                                         \
  do {                                                                                                                 \
    _Pragma("unroll") for (int _i = 0; _i < 2; ++_i) {                                                                 \
      const char* _ub = (const char*)(Wt + (size_t)((half) * 128 + _i * 64) * ldw + (kt) * 64);                        \
      __builtin_amdgcn_global_load_lds((const unsigned*)(_ub + offA), (LDS3 unsigned*)((P) + tid * 16 + _i * 8192), 16, 0, 0); \
    }                                                                                                                  \
  } while (0)
#define P8STAGE_B(P, half, kt)                                                                                         \
  do {                                                                                                                 \
    _Pragma("unroll") for (int _i = 0; _i < 2; ++_i) {                                                                 \
      const int _rb = (half) * 128 + _i * 64;                                                                          \
      const char* _ub; unsigned _of;                                                                                   \
      if (XMODE == 0) { _ub = (const char*)(Xt + (size_t)_rb * ldx + (kt) * 64); _of = offB; }                          \
      else {                                                                                                           \
        const bool _u = (kt) < 8;                                                                                      \
        _ub = _u ? (const char*)(Xt + (size_t)_rb * 16384 + (kt) * 2048) : (const char*)(X2 + (size_t)_rb * 8192 + ((kt) - 8) * 64); \
        _of = _u ? offB : offB2;                                                                                       \
      }                                                                                                                \
      __builtin_amdgcn_global_load_lds((const unsigned*)(_ub + _of), (LDS3 unsigned*)((P) + tid * 16 + _i * 8192), 16, 0, 0); \
    }                                                                                                                  \
  } while (0)
#define P8LDA(dst, b, h)                                                                                               \
  _Pragma("unroll") for (int m = 0; m < 4; ++m) _Pragma("unroll") for (int k = 0; k < 2; ++k)                          \
    dst[m][k] = *reinterpret_cast<const bf16x8*>(P8SA(b, h) + p8_lds_byte(wr * 64 + m * 16 + fr, k * 32 + fq * 8))
#define P8LDB(dst, b, h)                                                                                               \
  _Pragma("unroll") for (int n = 0; n < 2; ++n) _Pragma("unroll") for (int k = 0; k < 2; ++k)                          \
    dst[n][k] = *reinterpret_cast<const bf16x8*>(P8SB(b, h) + p8_lds_byte(wc * 32 + n * 16 + fr, k * 32 + fq * 8))
#define P8MMA(ai, bj, A_, B_)                                                                                          \
  do {                                                                                                                 \
    __builtin_amdgcn_s_setprio(1);                                                                                     \
    _Pragma("unroll") for (int m = 0; m < 4; ++m) _Pragma("unroll") for (int n = 0; n < 2; ++n)                        \
      _Pragma("unroll") for (int k = 0; k < 2; ++k)                                                                    \
        acc[ai][bj][m][n] = __builtin_amdgcn_mfma_f32_16x16x32_bf16(A_[m][k], B_[n][k], acc[ai][bj][m][n], 0, 0, 0);   \
    __builtin_amdgcn_s_setprio(0);                                                                                     \
  } while (0)
#define P8WV(n) asm volatile("s_waitcnt vmcnt(" #n ")" ::: "memory")
#define P8WL(n) asm volatile("s_waitcnt lgkmcnt(" #n ")" ::: "memory")
#define P8BAR __builtin_amdgcn_s_barrier()
#define P8SCHED __builtin_amdgcn_sched_barrier(0)
  bf16x8 At[4][2], B0[2][2], B1[2][2];
  P8STAGE_B(P8SB(0, 0), 0, 0); P8STAGE_A(P8SA(0, 0), 0, 0);
  P8STAGE_B(P8SB(0, 1), 1, 0); P8STAGE_A(P8SA(0, 1), 1, 0);
  if (wr == 1) P8BAR;
  P8WV(4); P8BAR;
  P8STAGE_B(P8SB(1, 0), 0, 1); P8STAGE_A(P8SA(1, 0), 0, 1); P8STAGE_B(P8SB(1, 1), 1, 1);
  P8WV(6); P8BAR;
#pragma nounroll
  for (int t = 0; t < nt - 2; t += 2) {
    P8LDB(B0, 0, 0); P8SCHED; P8LDA(At, 0, 0); P8STAGE_A(P8SA(1, 1), 1, t + 1);
    P8WL(8); P8BAR; P8WL(0); P8MMA(0, 0, At, B0); P8BAR; P8SCHED;
    P8LDB(B1, 0, 1); P8STAGE_B(P8SB(0, 0), 0, t + 2);
    P8BAR; P8WL(0); P8MMA(0, 1, At, B1); P8BAR;
    P8LDA(At, 0, 1); P8STAGE_A(P8SA(0, 0), 0, t + 2);
    P8BAR; P8WL(0); P8MMA(1, 0, At, B0); P8BAR; P8SCHED;
    P8STAGE_B(P8SB(0, 1), 1, t + 2);
    P8WV(6); P8BAR; P8MMA(1, 1, At, B1); P8BAR;
    P8LDB(B0, 1, 0); P8SCHED; P8LDA(At, 1, 0); P8STAGE_A(P8SA(0, 1), 1, t + 2);
    P8WL(8); P8BAR; P8WL(0); P8MMA(0, 0, At, B0); P8BAR; P8SCHED;
    P8LDB(B1, 1, 1); P8STAGE_B(P8SB(1, 0), 0, t + 3);
    P8BAR; P8WL(0); P8MMA(0, 1, At, B1); P8BAR;
    P8LDA(At, 1, 1); P8STAGE_A(P8SA(1, 0), 0, t + 3);
    P8BAR; P8WL(0); P8MMA(1, 0, At, B0); P8BAR; P8SCHED;
    P8STAGE_B(P8SB(1, 1), 1, t + 3);
    P8WV(6); P8BAR; P8MMA(1, 1, At, B1); P8BAR;
  }
  { P8LDB(B0, 0, 0); P8LDA(At, 0, 0); P8STAGE_A(P8SA(1, 1), 1, nt - 1);
    P8BAR; P8WL(0); P8MMA(0, 0, At, B0); P8BAR;
    P8LDB(B1, 0, 1); P8BAR; P8WL(0); P8MMA(0, 1, At, B1); P8BAR;
    P8LDA(At, 0, 1); P8WV(4); P8BAR; P8WL(0); P8MMA(1, 0, At, B0); P8MMA(1, 1, At, B1); P8BAR; }
  { P8LDB(B0, 1, 0); P8LDA(At, 1, 0); P8WV(2); P8BAR; P8WL(0); P8MMA(0, 0, At, B0); P8BAR;
    P8LDB(B1, 1, 1); P8WV(0); P8BAR; P8WL(0); P8MMA(0, 1, At, B1); P8BAR;
    P8LDA(At, 1, 1); P8BAR; P8WL(0); P8MMA(1, 0, At, B0); P8MMA(1, 1, At, B1); P8BAR; }
  if (wr == 0) P8BAR;
#undef P8SA
#undef P8SB
#undef P8STAGE_A
#undef P8STAGE_B
#undef P8LDA
#undef P8LDB
#undef P8MMA
#undef P8WV
#undef P8WL
#undef P8BAR
#undef P8SCHED
}

DI void zero_acc8(acc8_t& acc) {
#pragma unroll
  for (int a = 0; a < 2; ++a)
#pragma unroll
    for (int b = 0; b < 2; ++b)
#pragma unroll
      for (int m = 0; m < 4; ++m)
#pragma unroll
        for (int q = 0; q < 2; ++q) acc[a][b][m][q] = f32x4v{0.f, 0.f, 0.f, 0.f};
}
template <class F>
DI void epi8_iter(const acc8_t& acc, F f) {
  const int lane = tidx() & 63, wid = tidx() >> 6, wr = wid >> 2, wc = wid & 3, fr = lane & 15, fq = lane >> 4;
#pragma unroll
  for (int ai = 0; ai < 2; ++ai)
#pragma unroll
    for (int bj = 0; bj < 2; ++bj)
#pragma unroll
      for (int m = 0; m < 4; ++m)
#pragma unroll
        for (int q = 0; q < 2; ++q)
          f(bj * 128 + wc * 32 + q * 16 + fr, ai * 128 + wr * 64 + m * 16 + fq * 4, acc[ai][bj][m][q][0], acc[ai][bj][m][q][1],
            acc[ai][bj][m][q][2], acc[ai][bj][m][q][3]);
}

DI void phase_ssm_states(const Params& p, char* lds) {
  const bf16_t* u = (const bf16_t*)(p.ws + OFF_U);
  float* S = (float*)(p.ws + OFF_S);
  __syncthreads();
  for (int it = bidx(); it < 32 * 4; it += gridDim.x) {
    const int g = it >> 2, ct = it & 3;
    acc8_t acc; zero_acc8(acc);
    asm volatile("s_waitcnt vmcnt(0)" ::: "memory");
    gemm_main8<1>(acc, (const bf16_t*)(p.ws + OFF_WEND) + (size_t)g * 256 * 512, 512, u + (size_t)(ct * 256 * 32) * 512 + g * 16, 0, 8, lds);
    epi8_iter(acc, [&](int t, int n, float a, float b, float c, float d) {
      *(float4*)(S + ((size_t)(ct * 256 + t) * 32 + g) * 256 + n) = make_float4(a, b, c, d);
    });
  }
}

DI void phase_ssm_out(const Params& p, char* lds) {
  const bf16_t* u = (const bf16_t*)(p.ws + OFF_U);
  const bf16_t* xin = (const bf16_t*)(p.ws + OFF_XIN);
  bf16_t* yg = (bf16_t*)(p.ws + OFF_S);
  __syncthreads();
  for (int it = bidx(); it < 32 * 4 * 2; it += gridDim.x) {
    const int g = it >> 3, ct = (it >> 1) & 3, nt = it & 1;
    acc8_t acc; zero_acc8(acc);
    asm volatile("s_waitcnt vmcnt(0)" ::: "memory");
    gemm_main8<1>(acc, (const bf16_t*)(p.ws + OFF_WTOEP) + (size_t)g * 512 * 768 + (size_t)nt * 256 * 768, 768,
                  u + (size_t)(ct * 256 * 32) * 512 + g * 16, 0, 12, lds, xin + ((size_t)(ct * 256) * 32 + g) * 256);
    epi8_iter(acc, [&](int t, int n, float a, float b, float c, float d) {
      const int nn = nt * 256 + n, tt = nn >> 4, pp = nn & 15;
      const size_t tok = (size_t)(ct * 256 + t) * 32 + tt;
      const uint2 uu = *(const uint2*)(u + tok * 512 + g * 16 + pp);
      const float4 dd = *(const float4*)(p.ssm_d + g * 16 + pp);
      store_bf4(yg + tok * 512 + g * 16 + pp, gelu_tanh(a + dd.x * bf_lo(uu.x)), gelu_tanh(b + dd.y * bf_hi(uu.x)),
                gelu_tanh(c + dd.z * bf_lo(uu.y)), gelu_tanh(d + dd.w * bf_hi(uu.y)));
    });
  }
}

DI void phase_glu(const Params& p, char* lds) {
  const bf16_t* yg = (const bf16_t*)(p.ws + OFF_S);
  bf16_t* so = (bf16_t*)(p.ws + OFF_U);
  __syncthreads();
  for (int it = bidx(); it < 128 * 2; it += gridDim.x) {
    const int mt = it >> 1, nt = it & 1;
    acc8_t acc; zero_acc8(acc);
    asm volatile("s_waitcnt vmcnt(0)" ::: "memory");
    gemm_main8(acc, (const bf16_t*)(p.ws + OFF_WGLU) + (size_t)nt * 256 * 512, 512, yg + (size_t)mt * 256 * 512, 512, 8, lds);
    epi8_iter(acc, [&](int t, int n, float a, float b, float c, float d) {
      const size_t off = (size_t)(mt * 256 + t) * 512 + nt * 256 + n;
      const uint2 yy = *(const uint2*)(yg + off);
      const float4 bb = *(const float4*)(p.b_glu + nt * 256 + n);
      store_bf4(so + off, bf_lo(yy.x) * sigmoidf_(a + bb.x), bf_hi(yy.x) * sigmoidf_(b + bb.y), bf_lo(yy.y) * sigmoidf_(c + bb.z),
                bf_hi(yy.y) * sigmoidf_(d + bb.w));
    });
  }
}

DI void phase_merge(const Params& p, char* lds) {
  const bf16_t* at = (const bf16_t*)(p.ws + OFF_Q);
  const bf16_t* so = (const bf16_t*)(p.ws + OFF_U);
  const bf16_t* gates = (const bf16_t*)(p.ws + OFF_GATES);
  bf16_t* mg = (bf16_t*)(p.ws + OFF_K);
  __syncthreads();
  for (int it = bidx(); it < 128 * 4; it += gridDim.x) {
    const int r_ = it >> 8, w_ = it & 255;
    const int mt = 16 * (w_ & 7) + (r_ & 1) * 8 + (w_ >> 5), nt = (w_ >> 3) & 3;
    acc8_t acc; zero_acc8(acc);
    asm volatile("s_waitcnt vmcnt(0)" ::: "memory");
    gemm_main8(acc, (const bf16_t*)(p.ws + OFF_WPA) + (size_t)nt * 256 * 1024, 1024, at + (size_t)mt * 256 * 1024, 1024, 16, lds);
    epi8_iter(acc, [&](int t, int n, float a, float b, float c, float d) {
      const size_t tok = (size_t)mt * 256 + t;
      const int nn = nt * 256 + n;
      const uint2 ga = *(const uint2*)(gates + tok * 2048 + nn);
      store_bf4(mg + tok * 1024 + nn, bf_lo(ga.x) * a, bf_hi(ga.x) * b, bf_lo(ga.y) * c, bf_hi(ga.y) * d);
    });
    zero_acc8(acc);
    asm volatile("s_waitcnt vmcnt(0)" ::: "memory");
    gemm_main8(acc, (const bf16_t*)(p.ws + OFF_WPS) + (size_t)nt * 256 * 512, 512, so + (size_t)mt * 256 * 512, 512, 8, lds);
    epi8_iter(acc, [&](int t, int n, float a, float b, float c, float d) {
      const size_t tok = (size_t)mt * 256 + t;
      const int nn = nt * 256 + n;
      const uint2 gs = *(const uint2*)(gates + tok * 2048 + 1024 + nn);
      const uint2 pa = *(const uint2*)(mg + tok * 1024 + nn);
      store_bf4(mg + tok * 1024 + nn, bf_lo(pa.x) + bf_lo(gs.x) * a, bf_hi(pa.x) + bf_hi(gs.x) * b, bf_lo(pa.y) + bf_lo(gs.y) * c,
                bf_hi(pa.y) + bf_hi(gs.y) * d);
    });
  }
}

DI void phase_gemm_in(const Params& p, int hf, char* lds) {
  const bf16_t* h1 = (const bf16_t*)(p.ws + OFF_H1);
  const bf16_t* W = (const bf16_t*)(p.ws + OFF_WIN);
  const float2* rope = (const float2*)(p.ws + OFF_ROPE);
  const int lmask = (hf == 0 ? 16384 : 8192) - 1;
  constexpr int NTN = INW / 256;
  __syncthreads();
  for (int it = bidx(); it < 128 * NTN; it += gridDim.x) {
    const int mt = it / NTN, nt = it % NTN;
    acc8_t acc;
#pragma unroll
    for (int a = 0; a < 2; ++a)
#pragma unroll
      for (int b = 0; b < 2; ++b)
#pragma unroll
        for (int m = 0; m < 4; ++m)
#pragma unroll
          for (int q = 0; q < 2; ++q) acc[a][b][m][q] = f32x4v{0.f, 0.f, 0.f, 0.f};
    asm volatile("s_waitcnt vmcnt(0)" ::: "memory");
    gemm_main8(acc, W + (size_t)nt * 256 * 1024, 1024, h1 + (size_t)mt * 256 * 1024, 1024, 16, lds);
    const int lane = tidx() & 63, wid = tidx() >> 6, wr = wid >> 2, wc = wid & 3, fr = lane & 15, fq = lane >> 4;
    const int m0 = mt * 256;
#define EPI8(F)                                                                                                        \
  _Pragma("unroll") for (int ai = 0; ai < 2; ++ai) _Pragma("unroll") for (int bj = 0; bj < 2; ++bj)                    \
    _Pragma("unroll") for (int m = 0; m < 4; ++m) _Pragma("unroll") for (int q = 0; q < 2; ++q)                        \
      F(m0 + bj * 128 + wc * 32 + q * 16 + fr, ai * 128 + wr * 64 + m * 16 + fq * 4, acc[ai][bj][m][q][0],            \
        acc[ai][bj][m][q][1], acc[ai][bj][m][q][2], acc[ai][bj][m][q][3]);
    if (nt < 8) {
      const bool isq = nt < 4;
      unsigned char* dst8 = (unsigned char*)(p.ws + OFF_K) + (isq ? OFF_Q8 : 0) + (nt & 3) * 256;
      const float qs = isq ? 0.125f * 1.44269504089f : 1.0f;
#pragma unroll
      for (int bj = 0; bj < 2; ++bj)
#pragma unroll
        for (int q = 0; q < 2; ++q) {
          const int pos = (m0 + bj * 128 + wc * 32 + q * 16 + fr) & lmask;
#pragma unroll
          for (int j = 0; j < 4; ++j) {
            const float2 cs = rope[pos * 8 + (fq & 1) * 4 + j];
#pragma unroll
            for (int ai = 0; ai < 2; ++ai) {
              const float v = acc[ai][bj][0][q][j];
              const float pv = __shfl_xor(v, 32);
              acc[ai][bj][0][q][j] = (fq < 2) ? v * cs.x - pv * cs.y : v * cs.x + pv * cs.y;
            }
          }
        }
      if (!isq) {
#pragma unroll
        for (int ai = 0; ai < 2; ++ai) {
          float kn2 = 0.f;
#pragma unroll
          for (int bj = 0; bj < 2; ++bj)
#pragma unroll
            for (int q = 0; q < 2; ++q) {
              float ss = 0.f;
#pragma unroll
              for (int m = 0; m < 4; ++m)
#pragma unroll
                for (int j = 0; j < 4; ++j) ss += acc[ai][bj][m][q][j] * acc[ai][bj][m][q][j];
              ss += __shfl_xor(ss, 16);
              ss += __shfl_xor(ss, 32);
              kn2 = fmaxf(kn2, ss);
            }
#pragma unroll
          for (int o = 8; o >= 1; o >>= 1) kn2 = fmaxf(kn2, __shfl_xor(kn2, o));
          if (lane == 0) {
            const int bb = m0 >> (hf == 0 ? 14 : 13), hd = (nt & 3) * 2 + ai;
            atomicMax((unsigned*)(p.ws + OFF_KMAX) + (bb * 8 + hd) * 2 + wr, __float_as_uint(kn2));
          }
        }
      }
#define ST_QK(t, n, a, b, c, d)                                                                                        \
  {                                                                                                                    \
    int pk8 = __builtin_amdgcn_cvt_pk_fp8_f32((a) * qs, (b) * qs, 0, false);                                           \
    pk8 = __builtin_amdgcn_cvt_pk_fp8_f32((c) * qs, (d) * qs, pk8, true);                                              \
    *(int*)(dst8 + (size_t)(t) * 1024 + (n)) = pk8;                                                                    \
  }
      EPI8(ST_QK)
#undef ST_QK
    } else if (nt < 12) {
      bf16_t* dst = (bf16_t*)(p.ws + OFF_V) + (nt - 8) * 256;
#define ST_V(t, n, a, b, c, d) store_bf4(dst + (size_t)(t) * 1024 + (n), a, b, c, d)
      EPI8(ST_V)
#undef ST_V
    } else if (nt < 14) {
      bf16_t* dst = (bf16_t*)(p.ws + OFF_U) + (nt - 12) * 256;
#define ST_U(t, n, a, b, c, d) store_bf4(dst + (size_t)(t) * 512 + (n), a, b, c, d)
      EPI8(ST_U)
#undef ST_U
    } else {
      bf16_t* dst = (bf16_t*)(p.ws + OFF_GATES) + (nt - 14) * 256;
#define ST_G(t, n, a, b, c, d) store_bf4(dst + (size_t)(t) * 2048 + (n), sigmoidf_(a), sigmoidf_(b), sigmoidf_(c), sigmoidf_(d))
      EPI8(ST_G)
#undef ST_G
    }
#undef EPI8
  }
}

template <bool RELU2>
DI void phase_gemm_plain(const bf16_t* X, int K, const bf16_t* W, int N, bf16_t* out, char* lds) {
  const int ntn = N / 256;
  __syncthreads();
  for (int it = bidx(); it < 128 * ntn; it += gridDim.x) {
    int mt = it / ntn, nt = it % ntn;
    if (ntn == 4) {
      const int r = it >> 8, w = it & 255, x = w & 7, slot = w >> 3;
      mt = 16 * x + (r & 1) * 8 + (slot >> 2); nt = slot & 3;
    }
    acc8_t acc;
#pragma unroll
    for (int a = 0; a < 2; ++a)
#pragma unroll
      for (int b = 0; b < 2; ++b)
#pragma unroll
        for (int m = 0; m < 4; ++m)
#pragma unroll
          for (int q = 0; q < 2; ++q) acc[a][b][m][q] = f32x4v{0.f, 0.f, 0.f, 0.f};
    asm volatile("s_waitcnt vmcnt(0)" ::: "memory");
    gemm_main8(acc, W + (size_t)nt * 256 * K, K, X + (size_t)mt * 256 * K, K, K / 64, lds);
    const int lane = tidx() & 63, wid = tidx() >> 6, wr = wid >> 2, wc = wid & 3, fr = lane & 15, fq = lane >> 4;
#pragma unroll
    for (int ai = 0; ai < 2; ++ai)
#pragma unroll
      for (int bj = 0; bj < 2; ++bj)
#pragma unroll
        for (int m = 0; m < 4; ++m)
#pragma unroll
          for (int q = 0; q < 2; ++q) {
            float a = acc[ai][bj][m][q][0], b = acc[ai][bj][m][q][1], c = acc[ai][bj][m][q][2], d = acc[ai][bj][m][q][3];
            if (RELU2) { a = fmaxf(a, 0.f); a *= a; b = fmaxf(b, 0.f); b *= b; c = fmaxf(c, 0.f); c *= c; d = fmaxf(d, 0.f); d *= d; }
            const int tok = mt * 256 + bj * 128 + wc * 32 + q * 16 + fr, n = nt * 256 + ai * 128 + wr * 64 + m * 16 + fq * 4;
            store_bf4(out + (size_t)tok * N + n, a, b, c, d);
          }
  }
}

constexpr int A_KB = 64 * 256, A_STAGE = 2 * A_KB, A_NST = 4;
static_assert(A_NST * A_STAGE <= LDS_BYTES && 65536 <= LDS_BYTES, "lds");
#define RAW_BARRIER() do { asm volatile("s_waitcnt lgkmcnt(0)" ::: "memory"); __builtin_amdgcn_s_barrier(); } while (0)

typedef int v8i_t __attribute__((ext_vector_type(8)));
typedef unsigned u32x4_t __attribute__((ext_vector_type(4)));
DI void attn_item(const Params& p, int L, int b, int h, int qb, float lam, char* lds) {
  const int tid = tidx(), lane = tid & 63, wave = __builtin_amdgcn_readfirstlane(tid >> 6);
  const int lq = lane & 31, hi = lane >> 5, rg = wave & 3, m = wave >> 2;
  bf16_t* qg = (bf16_t*)(p.ws + OFF_Q);
  const unsigned char* kg8 = (const unsigned char*)(p.ws + OFF_K) + ((size_t)b * L) * 1024 + h * 128;
  const unsigned char* qg8 = (const unsigned char*)(p.ws + OFF_K) + OFF_Q8;
  const bf16_t* vg = (const bf16_t*)(p.ws + OFF_V) + (size_t)b * L * 1024 + h * 128;
  const size_t tok0 = (size_t)b * L + (size_t)qb * 128;
  v8i_t qf8;
  {
    const uint4* qp = (const uint4*)(qg8 + (tok0 + rg * 32 + lq) * 1024 + h * 128 + m * 64 + hi * 32);
    const uint4 q0 = qp[0], q1 = qp[1];
    qf8[0] = q0.x; qf8[1] = q0.y; qf8[2] = q0.z; qf8[3] = q0.w; qf8[4] = q1.x; qf8[5] = q1.y; qf8[6] = q1.z; qf8[7] = q1.w;
  }
  float q2 = 0.f;
#pragma unroll
  for (int w = 0; w < 8; ++w) {
    const float v0 = __builtin_amdgcn_cvt_f32_fp8(qf8[w], 0), v1 = __builtin_amdgcn_cvt_f32_fp8(qf8[w], 1);
    const float v2 = __builtin_amdgcn_cvt_f32_fp8(qf8[w], 2), v3 = __builtin_amdgcn_cvt_f32_fp8(qf8[w], 3);
    q2 += v0 * v0 + v1 * v1 + v2 * v2 + v3 * v3;
  }
  q2 = xhalf_sum(q2);
  const float kmx2 = ((const float*)(p.ws + OFF_KMAX))[(b * 8 + h) * 2 + m];
  const float sinit = -(sqrtf(q2 * kmx2) * 1.09f + 0.125f);
  f32x16 oacc[4];
#pragma unroll
  for (int e = 0; e < 4; ++e)
#pragma unroll
    for (int i = 0; i < 16; ++i) oacc[e][i] = 0.f;
  float lsum = 0.f;
  const int nkt = L / 64;
  const int krow = wave * 8 + (lane >> 3);
  const int gk = krow * 1024 + (((lane & 7) ^ ((krow >> 1) & 7)) * 16);
  const int drow = wave * 8 + (lane >> 4), dcp = lane & 15;
  const int gv0 = drow * 1024 + ((dcp ^ ((drow & 3) << 2)) * 8), gv1 = (drow + 4) * 1024 + ((dcp ^ (((drow + 4) & 3) << 2)) * 8);
  auto dma_tile = [&](int j) {
    char* st = lds + (j & 3) * A_STAGE;
    const unsigned char* kt = kg8 + (size_t)min(j + 1, nkt - 1) * 64 * 1024;
    const bf16_t* vt = vg + (size_t)j * 64 * 1024;
    __builtin_amdgcn_global_load_lds((const unsigned*)(kt + gk), (LDS3 unsigned*)(st + wave * 1024), 16, 0, 0);
    __builtin_amdgcn_global_load_lds((const unsigned*)(vt + gv0), (LDS3 unsigned*)(st + A_KB + wave * 8 * 256), 16, 0, 0);
    __builtin_amdgcn_global_load_lds((const unsigned*)(vt + gv1), (LDS3 unsigned*)(st + A_KB + wave * 8 * 256 + 4 * 256), 16, 0, 0);
  };
  __syncthreads();
  __builtin_amdgcn_global_load_lds((const unsigned*)(kg8 + gk), (LDS3 unsigned*)(lds + 3 * A_STAGE + wave * 1024), 16, 0, 0);
  dma_tile(0); dma_tile(1); dma_tile(2);
  LDS3 char* const l3 = (LDS3 char*)lds;
  int vro[4];
  const int kro = lq * 128 + (((m * 4 + hi * 2) ^ ((lq >> 1) & 7)) * 16);
  {
    const int tq = (lane & 15) >> 2, tp = lane & 3, blk = (lane >> 4) & 1;
#pragma unroll
    for (int eb = 0; eb < 4; ++eb) vro[eb] = A_KB + (4 * hi + tq) * 256 + ((((eb ^ tq) * 4) + blk * 2 + (tp >> 1)) * 16) + (tp & 1) * 8;
  }
#define SB() __builtin_amdgcn_sched_barrier(0)
#define TRR(dst, addr, imm) asm volatile("ds_read_b64_tr_b16 %0, %1 offset:%2" : "=&v"(dst) : "v"(addr), "n"(imm))
#define RV(g, st)                                                                                                     \
  TRR(vlo[g][0], vad[0], (st) * 4096); TRR(vhi[g][0], vad[0], (st) * 4096 + 2048);                                    \
  TRR(vlo[g][1], vad[1], (st) * 4096); TRR(vhi[g][1], vad[1], (st) * 4096 + 2048);                                    \
  TRR(vlo[g][2], vad[2], (st) * 4096); TRR(vhi[g][2], vad[2], (st) * 4096 + 2048);                                    \
  TRR(vlo[g][3], vad[3], (st) * 4096); TRR(vhi[g][3], vad[3], (st) * 4096 + 2048);
#define WAITV(n, g)                                                                                                   \
  asm volatile("s_waitcnt lgkmcnt(" #n ")"                                                                            \
               : "+v"(vlo[g][0]), "+v"(vhi[g][0]), "+v"(vlo[g][1]), "+v"(vhi[g][1]), "+v"(vlo[g][2]), "+v"(vhi[g][2]),  \
                 "+v"(vlo[g][3]), "+v"(vhi[g][3]));
#define MV(g, st)                                                                                                     \
  _Pragma("unroll") for (int eb = 0; eb < 4; ++eb)                                                                    \
    oacc[eb] = MFMA32(__builtin_shufflevector(vlo[g][eb], vhi[g][eb], 0, 1, 2, 3, 4, 5, 6, 7), pf[st], oacc[eb]);
  const unsigned lds_addr0 = (unsigned)(size_t)lds;
#define RK(dst, ks) dst[0] = *(const LDS3 bf16x8*)(l3 + kad[ks]); dst[1] = *(const LDS3 bf16x8*)(l3 + kad[ks] + 32 * 256);
#define QKM(src, ks) n0 = MFMA32(src[0], qf[ks], n0); n1 = MFMA32(src[1], qf[ks], n1);
#define EXP4(cx, i0) _Pragma("unroll") for (int i = (i0); i < (i0) + 4; ++i) { cx[i] = __builtin_amdgcn_exp2f(cx[i]); ps += cx[i]; }
#define PACK(dst, cx, o)                                                                                              \
  {                                                                                                                   \
    uint4 u;                                                                                                          \
    u.x = pack_bf16(cx[(o) + 0], cx[(o) + 1]); u.y = pack_bf16(cx[(o) + 2], cx[(o) + 3]);                             \
    u.z = pack_bf16(cx[(o) + 4], cx[(o) + 5]); u.w = pack_bf16(cx[(o) + 6], cx[(o) + 7]);                             \
    dst = __builtin_bit_cast(bf16x8, u);                                                                              \
  }
#define MVH(g, st, e0)                                                                                                \
  oacc[e0] = MFMA32(__builtin_shufflevector(vlo[g][e0], vhi[g][e0], 0, 1, 2, 3, 4, 5, 6, 7), pf[st], oacc[e0]);       \
  oacc[(e0) + 1] = MFMA32(__builtin_shufflevector(vlo[g][(e0) + 1], vhi[g][(e0) + 1], 0, 1, 2, 3, 4, 5, 6, 7), pf[st], oacc[(e0) + 1]);
  f32x16 sA0, sA1, sB0, sB1;
  f32x16 sv;
#pragma unroll
  for (int i = 0; i < 16; ++i) sv[i] = sinit;
#define LDK8(dst, base)                                                                                               \
  {                                                                                                                   \
    const u32x4_t _a = *(const LDS3 u32x4_t*)(l3 + (base)), _b = *(const LDS3 u32x4_t*)(l3 + ((base) ^ 16));          \
    dst[0] = _a[0]; dst[1] = _a[1]; dst[2] = _a[2]; dst[3] = _a[3]; dst[4] = _b[0]; dst[5] = _b[1]; dst[6] = _b[2]; dst[7] = _b[3]; \
  }
#define QK8(kf, cinit) __builtin_amdgcn_mfma_scale_f32_32x32x64_f8f6f4(kf, qf8, cinit, 0, 0, 0, 0x7F7F7F7F, 0, 0x7F7F7F7F)
  asm volatile("s_waitcnt vmcnt(0)" ::: "memory");
  RAW_BARRIER();
  {
    v8i_t k0, k1;
    LDK8(k0, 3 * A_STAGE + kro) LDK8(k1, 3 * A_STAGE + kro + 32 * 128)
    sA0 = QK8(k0, sv); sA1 = QK8(k1, sv);
  }
  auto step = [&](int t, f32x16& c0, f32x16& c1, f32x16& n0, f32x16& n1) {
    if (t + 2 < nkt) asm volatile("s_waitcnt vmcnt(6)" ::: "memory");
    else if (t + 1 < nkt) asm volatile("s_waitcnt vmcnt(3)" ::: "memory");
    else asm volatile("s_waitcnt vmcnt(0)" ::: "memory");
    RAW_BARRIER();
    const int so = (t & 3) * A_STAGE;
    int kad = so + kro, vad[4];
    asm volatile("" : "+v"(kad));
#pragma unroll
    for (int i = 0; i < 4; ++i) { vad[i] = (int)lds_addr0 + so + vro[i]; asm volatile("" : "+v"(vad[i])); }
    if (t + 3 < nkt) dma_tile(t + 3);
    bf16x8 pf[4];
    v8i_t kf0, kf1;
    s16x4 vlo[2][4], vhi[2][4];
    float ps = 0.f;
    SB();
    LDK8(kf0, kad) LDK8(kf1, kad + 32 * 128) RV(0, 0)
    SB();
    n0 = QK8(kf0, sv); EXP4(c0, 0) SB();
    EXP4(c0, 4) PACK(pf[0], c0, 0) SB();
    n1 = QK8(kf1, sv); EXP4(c0, 8) SB();
    RV(1, 1) SB(); EXP4(c0, 12) PACK(pf[1], c0, 8) SB();
    WAITV(8, 0) SB(); MVH(0, 0, 0) EXP4(c1, 0) SB(); MVH(0, 0, 2) EXP4(c1, 4) PACK(pf[2], c1, 0) SB();
    RV(0, 2) SB(); WAITV(8, 1) SB(); MVH(1, 1, 0) EXP4(c1, 8) SB(); MVH(1, 1, 2) EXP4(c1, 12) PACK(pf[3], c1, 8) SB();
    RV(1, 3) SB(); WAITV(8, 0) SB(); MV(0, 2) SB();
    WAITV(0, 1) SB(); MV(1, 3) SB();
    lsum += ps;
  };
#pragma nounroll
  for (int t = 0; t < nkt; t += 2) {
    step(t, sA0, sA1, sB0, sB1);
    step(t + 1, sB0, sB1, sA0, sA1);
  }
#undef RK
#undef QKM
#undef LDK8
#undef QK8
#undef EXP4
#undef PACK
#undef MVH
#undef SB
#undef RV
#undef MV
#undef TRR
#undef WAITV
  __syncthreads();
  const float ltot = xhalf_sum(lsum);
  float* xb = (float*)lds;
  if (m == 1) {
    const float sc = -lam / ltot;
#pragma unroll
    for (int e = 0; e < 4; ++e)
#pragma unroll
      for (int i = 0; i < 16; ++i) xb[(rg * 64 + e * 16 + i) * 64 + lane] = oacc[e][i] * sc;
  }
  __syncthreads();
  if (m == 0) {
    const float sc = 1.0f / ltot;
    float ss = 0.f;
#pragma unroll
    for (int e = 0; e < 4; ++e)
#pragma unroll
      for (int i = 0; i < 16; ++i) {
        const float o = oacc[e][i] * sc + xb[(rg * 64 + e * 16 + i) * 64 + lane];
        oacc[e][i] = o; ss += o * o;
      }
    ss = xhalf_sum(ss);
    const float rstd = rsqrtf(ss * (1.0f / 128.0f) + 1e-6f) * 0.8f;
    bf16_t* dst = qg + (tok0 + rg * 32 + lq) * 1024 + h * 128;
#pragma unroll
    for (int e = 0; e < 4; ++e)
#pragma unroll
      for (int gi = 0; gi < 4; ++gi) {
        const int ee = e * 32 + gi * 8 + hi * 4;
        const float4 gh = *(const float4*)(p.g_head + ee);
        store_bf4(dst + ee, oacc[e][gi * 4] * rstd * gh.x, oacc[e][gi * 4 + 1] * rstd * gh.y, oacc[e][gi * 4 + 2] * rstd * gh.z,
                  oacc[e][gi * 4 + 3] * rstd * gh.w);
      }
  }
  __syncthreads();
}

DI void phase_attn(const Params& p, int hf, char* lds) {
  const int L = hf == 0 ? 16384 : 8192, B = hf == 0 ? 2 : 4;
  for (int job = bidx(); job < B * 64; job += gridDim.x) ssm_scan_job(p, hf, job, lds);
  const float lam = ((const float*)(p.ws + OFF_SCAL))[0];
  const int nqb = L / 128, rpp = nqb / 32;
  for (int it = bidx(); it < 2048; it += gridDim.x) {
    const int r = it >> 8, w = it & 255, x = w & 7, slot = w >> 3;
    const int pair = x + 8 * (r / rpp), qb = (r % rpp) * 32 + slot;
    attn_item(p, L, pair >> 3, pair & 7, qb, lam, lds);
  }
}

__global__ void __launch_bounds__(NT) fwd_megakernel(Params p) {
  __shared__ __attribute__((aligned(16))) char lds[LDS_BYTES];
  cg::grid_group grid = cg::this_grid();
  phase0a(p, lds);
  grid.sync();
  phase0b(p);
  for (int hf = 0; hf < 2; ++hf) {
    phase_h1(p, hf);
    grid.sync();
    phase_gemm_in(p, hf, lds);
    grid.sync();
    phase_ssm_states(p, lds);
    grid.sync();
    phase_attn(p, hf, lds);
    grid.sync();
    phase_ssm_out(p, lds);
    grid.sync();
    phase_glu(p, lds);
    grid.sync();
    phase_merge(p, lds);
    grid.sync();
    phase_gemm_plain<false>((const bf16_t*)(p.ws + OFF_K), 1024, (const bf16_t*)(p.ws + OFF_WOUT), 1024, (bf16_t*)(p.ws + OFF_V), lds);
    grid.sync();
    phase_x1(p, hf);
    grid.sync();
    phase_gemm_plain<true>((const bf16_t*)(p.ws + OFF_H1), 1024, (const bf16_t*)(p.ws + OFF_WFF1), 4096, (bf16_t*)(p.ws + OFF_Q), lds);
    grid.sync();
    phase_gemm_plain<false>((const bf16_t*)(p.ws + OFF_Q), 4096, (const bf16_t*)(p.ws + OFF_WFF2), 1024, (bf16_t*)(p.ws + OFF_H1), lds);
    grid.sync();
    phase_final(p, hf);
    grid.sync();
  }
}

extern "C" void kernel_launch(void* const* d_in, const int* in_sizes, int n_in, void* d_out, int out_size, void* d_ws, size_t ws_size,
                              hipStream_t stream) {
  static int grid_blocks = 0;
  if (!grid_blocks) {
    int dev = 0, cus = 0, per_cu = 0;
    hipGetDevice(&dev);
    hipDeviceGetAttribute(&cus, hipDeviceAttributeMultiprocessorCount, dev);
    hipOccupancyMaxActiveBlocksPerMultiprocessor(&per_cu, fwd_megakernel, NT, 0);
    if (per_cu < 1) per_cu = 1;
    grid_blocks = cus * 1;
  }
  Params p{};
  const float* const* in = (const float* const*)d_in;
  p.x[0] = in[0]; p.x[1] = in[1]; p.c[0] = in[2]; p.c[1] = in[3];
  p.w_ada = in[4]; p.b_ada = in[5]; p.g_pre_mix = in[6]; p.g_post_mix = in[7]; p.g_pre_ffn = in[8]; p.g_post_ffn = in[9];
  p.w_in = in[10]; p.lam_q1 = in[11]; p.lam_k1 = in[12]; p.lam_q2 = in[13]; p.lam_k2 = in[14]; p.g_head = in[15];
  p.lam_re[0] = in[16]; p.lam_im[0] = in[17]; p.log_step[0] = in[18]; p.c_re[0] = in[19]; p.c_im[0] = in[20];
  p.lam_re[1] = in[21]; p.lam_im[1] = in[22]; p.log_step[1] = in[23]; p.c_re[1] = in[24]; p.c_im[1] = in[25];
  p.b_re = in[26]; p.b_im = in[27]; p.ssm_d = in[28]; p.w_glu = in[29]; p.b_glu = in[30]; p.w_pa = in[31]; p.w_ps = in[32];
  p.w_out = in[33]; p.w_ff1 = in[34]; p.w_ff2 = in[35];
  p.out = (float*)d_out;
  p.ws = (char*)d_ws;
  void* args[] = {&p};
  hipError_t e = hipLaunchCooperativeKernel((void*)fwd_megakernel, dim3(grid_blocks), dim3(NT), args, 0, stream);
  if (e != hipSuccess) fprintf(stderr, "cooperative launch failed: %s (grid %d)\n", hipGetErrorString(e), grid_blocks);
}
```
